# Optimizing an MI355X kernel written in HIP

```python
import jax, jax.numpy as jnp
from jax import lax
import numpy as np

D_MODEL = 1024
BATCH = 8
SEQ = 2048
DEPTH = 2

HEAD_DIM = 64
N_MIXERS = 4
N_HEADS = D_MODEL // (N_MIXERS * HEAD_DIM)
W_A = N_HEADS * HEAD_DIM
W_B = N_HEADS * HEAD_DIM
W_C = N_HEADS * HEAD_DIM
W_D = N_HEADS * HEAD_DIM
D_MIX = W_A + W_B + W_C + W_D
IN_COLS = 3 * W_A + 2 * W_B + 3 * W_C + 3 * W_D
MOBA_BLOCK = 256
MOBA_TOPK = 3
MOBA_Q_CHUNK = 32
SGU_CHUNK = 128
CONV_WIDTH = 3
DILATED_PATTERNS = ((128, 1), (512, 4), (2048, 16))
D_FF = 2816
N_EXPERTS = 8
TOP_K = 2
MOE_BLOCK = 256
N_DENSE = (DEPTH + 1) // 2
N_MOE = DEPTH // 2
RMS_EPS = 1e-6
LN_EPS = 1e-5
ATTN_SCALE = HEAD_DIM ** -0.5

kernel_name = 'hybrid_moba_sgu_conv_dilated_moe_block'


def rms_norm(x, g):
    xf = x.astype(jnp.float32)
    y = xf * lax.rsqrt(jnp.mean(xf * xf, axis=-1, keepdims=True) + RMS_EPS)
    return (y * g.astype(jnp.float32)).astype(x.dtype)


def layer_norm(x, g):
    xf = x.astype(jnp.float32)
    mu = jnp.mean(xf, axis=-1, keepdims=True)
    xc = xf - mu
    y = xc * lax.rsqrt(jnp.mean(xc * xc, axis=-1, keepdims=True) + LN_EPS)
    return (y * g.astype(jnp.float32)).astype(x.dtype)


def moba_attention(q, k, v):
    b, h, s, dh = q.shape
    nb = -(-s // MOBA_BLOCK)
    pad = nb * MOBA_BLOCK - s
    padw = ((0, 0), (0, 0), (0, pad), (0, 0))
    kb = jnp.pad(k, padw).reshape(b, h, nb, MOBA_BLOCK, dh)
    vb = jnp.pad(v, padw).reshape(b, h, nb, MOBA_BLOCK, dh)
    k_mean = jnp.mean(kb.astype(jnp.float32), axis=3)
    pos = jnp.arange(s)
    q_blk = pos // MOBA_BLOCK
    gate = jnp.einsum('bhsd,bhnd->bhsn', q.astype(jnp.float32), k_mean)
    past = jnp.arange(nb)[None, :] < q_blk[:, None]
    gate = jnp.where(past, gate, -jnp.inf)
    n_sel = min(MOBA_TOPK, nb)
    _, sel = lax.top_k(gate, n_sel)
    own = jnp.broadcast_to(q_blk[:, None], (b, h, s, 1)).astype(sel.dtype)
    idx = jnp.concatenate([sel, own], axis=-1)
    valid = jnp.concatenate([jnp.arange(n_sel)[None, :] < q_blk[:, None],
                             jnp.ones((s, 1), dtype=bool)], axis=-1)
    n = n_sel + 1
    qc = MOBA_Q_CHUNK
    nc = s // qc
    q_c = q.reshape(b, h, nc, qc, dh).transpose(2, 0, 1, 3, 4)
    idx_c = idx.reshape(b, h, nc, qc, n).transpose(2, 0, 1, 3, 4)
    valid_c = valid.reshape(nc, qc, n)
    pos_c = pos.reshape(nc, qc)
    bi = jnp.arange(b)[:, None, None, None]
    hi = jnp.arange(h)[None, :, None, None]
    offs = jnp.arange(MOBA_BLOCK)

    def attend_chunk(args):
        qq, ii, vv, tt = args
        kg = kb[bi, hi, ii]
        vg = vb[bi, hi, ii]
        kpos = ii[..., None] * MOBA_BLOCK + offs
        mask = vv[None, None, :, :, None] & (kpos <= tt[None, None, :, None, None])
        sc = jnp.einsum('bhqd,bhqnkd->bhqnk', qq, kg).astype(jnp.float32) * ATTN_SCALE
        sc = jnp.where(mask, sc, -jnp.inf).reshape(b, h, qc, n * MOBA_BLOCK)
        p = jax.nn.softmax(sc, axis=-1).reshape(b, h, qc, n, MOBA_BLOCK).astype(v.dtype)
        return jnp.einsum('bhqnk,bhqnkd->bhqd', p, vg)

    out = lax.map(attend_chunk, (q_c, idx_c, valid_c, pos_c))
    return out.transpose(1, 2, 0, 3, 4).reshape(b, h, s, dh)


def banded_causal_attention(q, k, v, reach):
    *lead, m, dh = q.shape
    blk = reach
    nblk = -(-m // blk)
    pad = nblk * blk - m
    padw = [(0, 0)] * len(lead) + [(0, pad), (0, 0)]

    def blocks(t):
        return jnp.pad(t, padw).reshape(*lead, nblk, blk, dh)

    def with_prev(t):
        prev = jnp.concatenate([jnp.zeros_like(t[..., :1, :, :]), t[..., :-1, :, :]], axis=-3)
        return jnp.concatenate([prev, t], axis=-2)

    qb = blocks(q)
    kw = with_prev(blocks(k))
    vw = with_prev(blocks(v))
    qi = jnp.arange(blk)[:, None] + blk
    kj = jnp.arange(2 * blk)[None, :]
    rel = qi - kj
    band = (rel >= 0) & (rel <= reach)
    has_prev = (jnp.arange(nblk) > 0)[:, None, None] | (kj >= blk)[None]
    mask = band[None] & has_prev
    sc = jnp.einsum('...nqd,...nkd->...nqk', qb, kw).astype(jnp.float32) * ATTN_SCALE
    sc = jnp.where(mask, sc, -jnp.inf)
    lse = jax.nn.logsumexp(sc, axis=-1)
    p = jnp.exp(sc - lse[..., None]).astype(v.dtype)
    o = jnp.einsum('...nqk,...nkd->...nqd', p, vw)
    o = o.reshape(*lead, nblk * blk, dh)[..., :m, :]
    lse = lse.reshape(*lead, nblk * blk)[..., :m]
    return o, lse


def dilated_mixture_attention(q, k, v):
    b, h, s, dh = q.shape
    outs, lses = [], []
    for window, dil in DILATED_PATTERNS:
        m = s // dil
        qs = q.reshape(b, h, m, dil, dh).transpose(0, 1, 3, 2, 4)
        ks = k.reshape(b, h, m, dil, dh).transpose(0, 1, 3, 2, 4)
        vs = v.reshape(b, h, m, dil, dh).transpose(0, 1, 3, 2, 4)
        o, lse = banded_causal_attention(qs, ks, vs, window // dil)
        outs.append(o.transpose(0, 1, 3, 2, 4).reshape(b, h, s, dh))
        lses.append(lse.transpose(0, 1, 3, 2).reshape(b, h, s))
    wts = jax.nn.softmax(jnp.stack(lses, axis=0), axis=0)
    return jnp.einsum('pbhs,pbhsd->bhsd', wts.astype(q.dtype), jnp.stack(outs, axis=0))


def spatial_gating(z_b, ln_g, w_s, b_s):
    b, s, _ = z_b.shape
    u, v = jnp.split(jax.nn.gelu(z_b), 2, axis=-1)
    v = layer_norm(v, ln_g)
    v = v.reshape(b, s // SGU_CHUNK, SGU_CHUNK, N_HEADS, W_B // N_HEADS)
    causal = jnp.tril(jnp.ones((SGU_CHUNK, SGU_CHUNK), w_s.dtype))
    sv = jnp.einsum('gts,bnsgc->bntgc', w_s * causal, v) + b_s.T[:, :, None]
    return u * sv.reshape(b, s, W_B)


def short_conv_mixer(z_c, conv_w):
    s = z_c.shape[1]
    bg, cg, xc = jnp.split(z_c, 3, axis=-1)
    z = cg * xc
    zp = jnp.pad(z, ((0, 0), (CONV_WIDTH - 1, 0), (0, 0)))
    y = zp[:, 0:s] * conv_w[0]
    for tap in range(1, CONV_WIDTH):
        y = y + zp[:, tap:tap + s] * conv_w[tap]
    return bg * y


def hybrid_mixer(h, w_in, sgu_ln_g, sgu_w, sgu_b, conv_w, w_out):
    b, s, _ = h.shape
    z = h @ w_in
    cut1 = 3 * W_A
    cut2 = cut1 + 2 * W_B
    cut3 = cut2 + 3 * W_C
    z_a, z_b, z_c, z_d = jnp.split(z, [cut1, cut2, cut3], axis=-1)

    def heads(t):
        return t.reshape(b, s, 3, N_HEADS, HEAD_DIM).transpose(2, 0, 3, 1, 4)

    qa, ka, va = heads(z_a)
    y_a = moba_attention(qa, ka, va).transpose(0, 2, 1, 3).reshape(b, s, W_A)
    y_b = spatial_gating(z_b, sgu_ln_g, sgu_w, sgu_b)
    y_c = short_conv_mixer(z_c, conv_w)
    qd, kd, vd = heads(z_d)
    y_d = dilated_mixture_attention(qd, kd, vd).transpose(0, 2, 1, 3).reshape(b, s, W_D)
    return jnp.concatenate([y_a, y_b, y_c, y_d], axis=-1) @ w_out


def swiglu(h, w_gate, w_up, w_down):
    return (jax.nn.silu(h @ w_gate) * (h @ w_up)) @ w_down


def moe_swiglu(h, w_router, w_gate, w_up, w_down):
    b, s, d = h.shape
    x = h.reshape(-1, d)
    n = x.shape[0]
    logits = (x @ w_router).astype(jnp.float32)
    top_val, top_idx = lax.top_k(logits, TOP_K)
    gates = jax.nn.softmax(top_val, axis=-1)
    flat_e = top_idx.reshape(-1)
    flat_tok = jnp.arange(n * TOP_K) // TOP_K
    flat_g = gates.reshape(-1)
    order = jnp.argsort(flat_e)
    se = flat_e[order]
    stok = flat_tok[order]
    sg = flat_g[order]
    counts = jnp.bincount(flat_e, length=N_EXPERTS)
    starts = jnp.cumsum(counts) - counts
    padded = ((counts + MOE_BLOCK - 1) // MOE_BLOCK) * MOE_BLOCK
    pends = jnp.cumsum(padded)
    pstarts = pends - padded
    rank = jnp.arange(n * TOP_K) - starts[se]
    dest = pstarts[se] + rank
    nblocks = -(-(n * TOP_K) // MOE_BLOCK) + N_EXPERTS
    cap = nblocks * MOE_BLOCK
    xbuf = jnp.zeros((cap, d), x.dtype).at[dest].set(x[stok])
    block_e = jnp.minimum(jnp.searchsorted(pends, jnp.arange(nblocks) * MOE_BLOCK, side='right'),
                          N_EXPERTS - 1)

    def expert_block(args):
        xb, e = args
        return (jax.nn.silu(xb @ w_gate[e]) * (xb @ w_up[e])) @ w_down[e]

    ybuf = lax.map(expert_block, (xbuf.reshape(nblocks, MOE_BLOCK, d), block_e)).reshape(cap, d)
    y = ybuf[dest] * sg[:, None].astype(x.dtype)
    out = jax.ops.segment_sum(y, stok, num_segments=n)
    return out.reshape(b, s, d)


def setup_inputs(seed: int = 0) -> dict:
    key = jax.random.key(seed)
    ks = jax.random.split(key, 18)

    def nrm(k, shape, scale):
        return jax.random.normal(k, shape, jnp.float32) * scale

    return {
        'x': nrm(ks[0], (BATCH, SEQ, D_MODEL), 1.0),
        'g_mix': 1.0 + nrm(ks[1], (DEPTH, D_MODEL), 0.02),
        'w_in': nrm(ks[2], (DEPTH, D_MODEL, IN_COLS), D_MODEL ** -0.5),
        'sgu_ln_g': 1.0 + nrm(ks[3], (DEPTH, W_B), 0.02),
        'sgu_w': nrm(ks[4], (DEPTH, N_HEADS, SGU_CHUNK, SGU_CHUNK), SGU_CHUNK ** -0.5),
        'sgu_b': nrm(ks[5], (DEPTH, N_HEADS, SGU_CHUNK), 0.02),
        'conv_w': nrm(ks[6], (DEPTH, CONV_WIDTH, W_C), CONV_WIDTH ** -0.5),
        'w_out': nrm(ks[7], (DEPTH, D_MIX, D_MODEL), D_MIX ** -0.5),
        'g_ffn': 1.0 + nrm(ks[8], (DEPTH, D_MODEL), 0.02),
        'dense_w_gate': nrm(ks[9], (N_DENSE, D_MODEL, D_FF), D_MODEL ** -0.5),
        'dense_w_up': nrm(ks[10], (N_DENSE, D_MODEL, D_FF), D_MODEL ** -0.5),
        'dense_w_down': nrm(ks[11], (N_DENSE, D_FF, D_MODEL), D_FF ** -0.5),
        'router_w': nrm(ks[12], (N_MOE, D_MODEL, N_EXPERTS), D_MODEL ** -0.5),
        'moe_w_gate': nrm(ks[13], (N_MOE, N_EXPERTS, D_MODEL, D_FF), D_MODEL ** -0.5),
        'moe_w_up': nrm(ks[14], (N_MOE, N_EXPERTS, D_MODEL, D_FF), D_MODEL ** -0.5),
        'moe_w_down': nrm(ks[15], (N_MOE, N_EXPERTS, D_FF, D_MODEL), D_FF ** -0.5),
        'g_final': 1.0 + nrm(ks[16], (D_MODEL,), 0.02),
    }


def reference(x, g_mix, w_in, sgu_ln_g, sgu_w, sgu_b, conv_w, w_out, g_ffn,
              dense_w_gate, dense_w_up, dense_w_down, router_w,
              moe_w_gate, moe_w_up, moe_w_down, g_final):
    for l in range(DEPTH):
        h = rms_norm(x, g_mix[l])
        x = x + hybrid_mixer(h, w_in[l], sgu_ln_g[l], sgu_w[l], sgu_b[l], conv_w[l], w_out[l])
        h = rms_norm(x, g_ffn[l])
        j = l // 2
        if l % 2 == 0:
            x = x + swiglu(h, dense_w_gate[j], dense_w_up[j], dense_w_down[j])
        else:
            x = x + moe_swiglu(h, router_w[j], moe_w_gate[j], moe_w_up[j], moe_w_down[j])
    return rms_norm(x, g_final)
```

```cpp
#include <hip/hip_runtime.h>
#include <cstdio>
#include <cstdint>

#define GAS __attribute__((address_space(1)))
#define LAS __attribute__((address_space(3)))
typedef unsigned short bf16_t;
typedef short bf16x8 __attribute__((ext_vector_type(8)));
typedef float f32x4 __attribute__((ext_vector_type(4)));
typedef float f32x2 __attribute__((ext_vector_type(2)));
typedef unsigned u32x4 __attribute__((ext_vector_type(4)));
typedef unsigned u32x2 __attribute__((ext_vector_type(2)));

#ifndef MK_N_LAUNCHES
#define MK_N_LAUNCHES 1
#endif
#ifndef PHMASK
#define PHMASK 0x3ff
#endif
#define PHC(c) (((PHMASK) >> (c)) & 1)

constexpr int NBATCH = 8, SEQ = 2048, T = NBATCH * SEQ, D = 1024, INC = 2816, FF = 2816, NEXP = 8, GU = 2 * FF;
constexpr int MAXRB = 135;
constexpr float RMS_EPS = 1e-6f, LN_EPS = 1e-5f;
constexpr float QSCALE = 0.125f * 1.4426950408889634f;
constexpr int NPHASE = 13;

constexpr size_t KiB = 1024, MiB = 1u << 20, HMiB = 1u << 19;
constexpr size_t WS_CTL = 0, CTL_ZERO_BYTES = 1 * MiB;
constexpr size_t WS_RSS = 1 * MiB;
constexpr size_t WS_RINV = WS_RSS + 256 * KiB;
constexpr size_t WS_KPART = WS_RINV + 64 * KiB;
constexpr size_t WS_TOKOF = 2 * MiB;
constexpr size_t WS_GROW = WS_TOKOF + 512 * KiB;
constexpr size_t WS_TSLOT = 3 * MiB;
constexpr size_t WS_WIN = 4 * MiB;
constexpr size_t WS_WOUT = 15 * MiB;
constexpr size_t WS_WGU0 = 19 * MiB;
constexpr size_t WS_WDN0 = 30 * MiB;
constexpr size_t WS_MWDN = 71 * HMiB;
constexpr size_t WS_MWGU = 159 * HMiB;
constexpr size_t WS_XB = 335 * HMiB;
constexpr size_t WS_Z = 399 * HMiB;
constexpr size_t WS_Y = 575 * HMiB;
constexpr size_t WS_H = WS_Z;
constexpr size_t WS_MH = WS_Z;
constexpr size_t WS_YB = WS_MWGU;
constexpr size_t WS_END = WS_MH + (size_t)MAXRB * 256 * FF * 2;
static_assert(WS_WIN + 2 * (size_t)INC * D * 2 <= WS_WOUT && WS_WOUT + 2 * (size_t)D * D * 2 <= WS_WGU0 && WS_WGU0 + (size_t)GU * D * 2 <= WS_WDN0 && WS_WDN0 + (size_t)D * FF * 2 <= WS_MWDN, "ws map 1");
static_assert(WS_MWDN + 8 * (size_t)D * FF * 2 <= WS_MWGU && WS_MWGU + 8 * (size_t)GU * D * 2 <= WS_XB && WS_XB + (size_t)T * D * 2 <= WS_Z && WS_Z + (size_t)T * INC * 2 <= WS_Y, "ws map 2");
static_assert(WS_YB + (size_t)MAXRB * 256 * D * 2 <= WS_XB && WS_TSLOT + (size_t)T * 8 <= WS_WIN && WS_KPART + 64 * 2 * 256 * 4 <= WS_TOKOF, "ws map 3");
constexpr int CW_TMO = 0, CW_CODE = 1;
constexpr int CW_CNT = 64;
constexpr int CW_BAR = 4096;

constexpr int RING_BYTES = 131072;
constexpr int LDSCTL_OFF = RING_BYTES, MISC_OFF = LDSCTL_OFF + 320;
constexpr int LDS_BYTES = 147456;
constexpr int NWAVES = 8;

#define LDS_WAIT() asm volatile("s_waitcnt lgkmcnt(0)" ::: "memory")
#define VM_WAIT() asm volatile("s_waitcnt vmcnt(0)" ::: "memory")
#define RLX_AGENT __ATOMIC_RELAXED, __HIP_MEMORY_SCOPE_AGENT
typedef GAS unsigned gu32;

__device__ __forceinline__ unsigned cvt_pk_bf16(float lo, float hi) { unsigned r; asm volatile("v_cvt_pk_bf16_f32 %0, %1, %2" : "=v"(r) : "v"(lo), "v"(hi)); return r; }
__device__ __forceinline__ float bf_lo(unsigned w) { return __uint_as_float(w << 16); }
__device__ __forceinline__ float bf_hi(unsigned w) { return __uint_as_float(w & 0xffff0000u); }
__device__ __forceinline__ float fast_exp2(float x) { return __builtin_amdgcn_exp2f(x); }
__device__ __forceinline__ float fast_rcp(float x) { return __builtin_amdgcn_rcpf(x); }
__device__ __forceinline__ float silu_f(float g) { return g * fast_rcp(1.f + fast_exp2(-1.4426950408889634f * g)); }
__device__ __forceinline__ float gelu_tanh(float x) { const float u = 0.7978845608028654f * (x + 0.044715f * x * x * x); return x * fast_rcp(1.f + fast_exp2(-2.8853900817779268f * u)); }
__device__ __forceinline__ float wave_sum(float v) {
#pragma unroll
    for (int o = 1; o < 64; o <<= 1) v += __shfl_xor(v, o);
    return v;
}

namespace pg8 {
#define PG8_LAS __attribute__((address_space(3)))
constexpr int BM = 256, BK = 64, HALF = 128, HTB = HALF * BK * 2, STAGE_BYTES = 8 * HTB, NXCD = 8, WGM = 8;
__host__ __device__ __forceinline__ int lds_byte(int r, int c) { const int st = (r >> 4) * 2 + (c >> 5), rr = r & 15, cc = c & 31, ob = rr * 64 + cc * 2; return st * 1024 + (ob ^ (((ob >> 9) & 1) << 5)); }
__host__ __device__ __forceinline__ void stage_rc(int b, int& R, int& C) { const int st = b / 1024, sb = b % 1024, swz = sb ^ (((sb >> 9) & 1) << 5); R = (st >> 1) * 16 + swz / 64; C = (st & 1) * 32 + (swz % 64) / 2; }
__host__ __device__ __forceinline__ int perm32(int rho) { const int n = rho >> 4, i = rho & 15; return 8 * (i >> 2) + 4 * n + (i & 3); }

struct Unit { int pm, pn, e, rb, ce; };

__device__ __forceinline__ bool tile_order(int i, int G, int c, int nM, int nN, int& pm, int& pn) {
    const int nwg = nM * nN; const long L = (long)i * G + c; if (L >= nwg) return false;
    int wgid = (int)L; { const int q = nwg / NXCD, r = nwg % NXCD, xcd = wgid % NXCD, off = wgid / NXCD; wgid = (xcd < r ? xcd * (q + 1) : r * (q + 1) + (xcd - r) * q) + off; }
    const int nig = WGM * nN, gid = wgid / nig, fm = gid * WGM, gsz = (nM - fm) < WGM ? (nM - fm) : WGM;
    pm = fm + ((wgid % nig) % gsz); pn = (wgid % nig) / gsz; return true;
}
struct StaticOrder {
    static constexpr bool GATHER = false;
    int nM, nN, G, c; const char* A; const char* Bt; size_t tstep;
    __device__ __forceinline__ void init(const void* A_, const void* Bt_, int M, int N, int K, int G_, int c_) { nM = M / BM; nN = N / BM; G = G_; c = c_; A = (const char*)A_; Bt = (const char*)Bt_; tstep = (size_t)BM * K * 2; }
    __device__ __forceinline__ bool next(int i, Unit& u) const { u.e = 0; u.rb = 0; u.ce = 0; return tile_order(i, G, c, nM, nN, u.pm, u.pn); }
    __device__ __forceinline__ const char* a_ptr(const Unit& u) const { return A + (size_t)u.pm * tstep; }
    __device__ __forceinline__ const char* b_ptr(const Unit& u) const { return Bt + (size_t)u.pn * tstep; }
    __device__ __forceinline__ void a_voff(const Unit&, const int (&)[2], const int (&)[2], int, unsigned (&)[2][2]) const {}
};
struct MoeOrder {
    int nM, nN, G, c; const char* A; const char* Bt; size_t tstep, estride; const int* tokof;
    int pb[8], cn[8];
    __device__ __forceinline__ void locate(int pm, int& e, int& rb, int& ce) const {
        e = 0; rb = pm; ce = cn[0];
#pragma unroll
        for (int j = 1; j < 8; ++j) if (pm >= pb[j]) { e = j; rb = pm - pb[j]; ce = cn[j]; }
    }
    __device__ __forceinline__ bool next(int i, Unit& u) const { if (!tile_order(i, G, c, nM, nN, u.pm, u.pn)) return false; locate(u.pm, u.e, u.rb, u.ce); return true; }
    __device__ __forceinline__ const char* b_ptr(const Unit& u) const { return Bt + (size_t)u.e * estride + (size_t)u.pn * tstep; }
};
struct MoeGatherOrder : MoeOrder {
    static constexpr bool GATHER = true;
    __device__ __forceinline__ const char* a_ptr(const Unit&) const { return A; }
    __device__ __forceinline__ void a_voff(const Unit& u, const int (&R)[2], const int (&C)[2], int K, unsigned (&v)[2][2]) const {
#pragma unroll
        for (int h = 0; h < 2; ++h)
#pragma unroll
            for (int i = 0; i < 2; ++i) { const int r = u.rb * 256 + h * HALF + R[i]; int tok = 0; if (r < u.ce) tok = tokof[u.e * 16384 + r]; v[h][i] = (unsigned)(tok * K + C[i]) * 2u; }
    }
};
struct MoePlainOrder : MoeOrder {
    static constexpr bool GATHER = false;
    __device__ __forceinline__ const char* a_ptr(const Unit& u) const { return A + (size_t)u.pm * tstep; }
    __device__ __forceinline__ void a_voff(const Unit&, const int (&)[2], const int (&)[2], int, unsigned (&)[2][2]) const {}
};

__device__ __forceinline__ float row_rinv(const float* rss, int r) { const float ss = (rss[r] + rss[T + r]) + (rss[2 * T + r] + rss[3 * T + r]); return __builtin_amdgcn_rsqf(ss * (1.0f / D) + RMS_EPS); }

struct EpiIn {
    static constexpr bool PERM = true, AFTER_DRAIN = false;
    bf16_t* Z; const float* rss; float* kpart;
    __device__ __forceinline__ void operator()(const f32x4 (&acc)[2][2][4][2], const Unit& u, int wr, int wc, int fr, int fq) const {
        const int row0 = u.pm * BM + wr * 64 + fr; const int col0 = u.pn * BM + wc * 32 + 8 * fq;
        const float sc = (u.pn == 0 || u.pn == 8) ? QSCALE : 1.f;
        const bool ksum_tile = (u.pn == 1);
        f32x4 ks[2][2];
#pragma unroll
        for (int bj = 0; bj < 2; ++bj)
#pragma unroll
            for (int n = 0; n < 2; ++n) ks[bj][n] = (f32x4){0.f, 0.f, 0.f, 0.f};
        float riv[2][4];
#pragma unroll
        for (int ai = 0; ai < 2; ++ai)
#pragma unroll
            for (int m = 0; m < 4; ++m) riv[ai][m] = row_rinv(rss, row0 + ai * HALF + m * 16) * sc;
#pragma unroll
        for (int ai = 0; ai < 2; ++ai)
#pragma unroll
            for (int m = 0; m < 4; ++m) { const int r = row0 + ai * HALF + m * 16; const float ri = riv[ai][m]; bf16_t* rowp = Z + (size_t)r * INC + col0;
#pragma unroll
                for (int bj = 0; bj < 2; ++bj) { const f32x4 v0 = acc[ai][bj][m][0] * ri, v1 = acc[ai][bj][m][1] * ri;
                    if (ksum_tile) { ks[bj][0] += v0; ks[bj][1] += v1; }
                    u32x4 w; w.x = cvt_pk_bf16(v0[0], v0[1]); w.y = cvt_pk_bf16(v0[2], v0[3]); w.z = cvt_pk_bf16(v1[0], v1[1]); w.w = cvt_pk_bf16(v1[2], v1[3]);
                    *(u32x4*)(rowp + bj * HALF) = w; } }
        if (ksum_tile) {
#pragma unroll
            for (int bj = 0; bj < 2; ++bj)
#pragma unroll
                for (int n = 0; n < 2; ++n)
#pragma unroll
                    for (int e = 0; e < 4; ++e) { float s = ks[bj][n][e]; s += __shfl_xor(s, 1); s += __shfl_xor(s, 2); s += __shfl_xor(s, 4); s += __shfl_xor(s, 8); ks[bj][n][e] = s; }
            if (fr == 0) { float* kp = kpart + ((size_t)u.pm * 2 + wr) * 256 + wc * 32 + 8 * fq;
#pragma unroll
                for (int bj = 0; bj < 2; ++bj) { *(f32x4*)(kp + bj * HALF) = ks[bj][0]; *(f32x4*)(kp + bj * HALF + 4) = ks[bj][1]; } }
        }
    }
};
struct EpiGU {
    static constexpr bool PERM = true, AFTER_DRAIN = false;
    bf16_t* H; const float* rss;
    __device__ __forceinline__ void operator()(const f32x4 (&acc)[2][2][4][2], const Unit& u, int wr, int wc, int fr, int fq) const {
        const int row0 = u.pm * BM + wr * 64 + fr; const int col0 = u.pn * HALF + wc * 32 + 8 * fq;
        float riv[2][4];
#pragma unroll
        for (int ai = 0; ai < 2; ++ai)
#pragma unroll
            for (int m = 0; m < 4; ++m) riv[ai][m] = row_rinv(rss, row0 + ai * HALF + m * 16);
#pragma unroll
        for (int ai = 0; ai < 2; ++ai)
#pragma unroll
            for (int m = 0; m < 4; ++m) { const int r = row0 + ai * HALF + m * 16; const float ri = riv[ai][m];
                float hv[8];
#pragma unroll
                for (int n = 0; n < 2; ++n)
#pragma unroll
                    for (int e = 0; e < 4; ++e) hv[4 * n + e] = silu_f(acc[ai][0][m][n][e] * ri) * (acc[ai][1][m][n][e] * ri);
                u32x4 w; w.x = cvt_pk_bf16(hv[0], hv[1]); w.y = cvt_pk_bf16(hv[2], hv[3]); w.z = cvt_pk_bf16(hv[4], hv[5]); w.w = cvt_pk_bf16(hv[6], hv[7]);
                *(u32x4*)(H + (size_t)r * FF + col0) = w; }
    }
};
struct EpiGUMoe {
    static constexpr bool PERM = true, AFTER_DRAIN = false;
    bf16_t* H; const float* rinvtok; const int* tokof;
    __device__ __forceinline__ void operator()(const f32x4 (&acc)[2][2][4][2], const Unit& u, int wr, int wc, int fr, int fq) const {
        const int rl0 = wr * 64 + fr; const int col0 = u.pn * HALF + wc * 32 + 8 * fq;
        int tkv[2][4]; float riv[2][4];
#pragma unroll
        for (int ai = 0; ai < 2; ++ai)
#pragma unroll
            for (int m = 0; m < 4; ++m) { const int re = u.rb * 256 + rl0 + ai * HALF + m * 16; int tok = 0; if (re < u.ce) tok = tokof[u.e * 16384 + re]; tkv[ai][m] = tok; }
#pragma unroll
        for (int ai = 0; ai < 2; ++ai)
#pragma unroll
            for (int m = 0; m < 4; ++m) riv[ai][m] = rinvtok[tkv[ai][m]];
#pragma unroll
        for (int ai = 0; ai < 2; ++ai)
#pragma unroll
            for (int m = 0; m < 4; ++m) { const int rl = rl0 + ai * HALF + m * 16; const float ri = riv[ai][m];
                float hv[8];
#pragma unroll
                for (int n = 0; n < 2; ++n)
#pragma unroll
                    for (int e = 0; e < 4; ++e) hv[4 * n + e] = silu_f(acc[ai][0][m][n][e] * ri) * (acc[ai][1][m][n][e] * ri);
                u32x4 w; w.x = cvt_pk_bf16(hv[0], hv[1]); w.y = cvt_pk_bf16(hv[2], hv[3]); w.z = cvt_pk_bf16(hv[4], hv[5]); w.w = cvt_pk_bf16(hv[6], hv[7]);
                *(u32x4*)(H + (size_t)(u.pm * BM + rl) * FF + col0) = w; }
    }
};
struct EpiDnMoe {
    static constexpr bool PERM = true, AFTER_DRAIN = false;
    bf16_t* YB; const float* grow;
    __device__ __forceinline__ void operator()(const f32x4 (&acc)[2][2][4][2], const Unit& u, int wr, int wc, int fr, int fq) const {
        const int rl0 = wr * 64 + fr; const int col0 = u.pn * BM + wc * 32 + 8 * fq;
        float gwv[2][4];
#pragma unroll
        for (int ai = 0; ai < 2; ++ai)
#pragma unroll
            for (int m = 0; m < 4; ++m) { const int re = u.rb * 256 + rl0 + ai * HALF + m * 16; float gw = 0.f; if (re < u.ce) gw = grow[u.e * 16384 + re]; gwv[ai][m] = gw; }
#pragma unroll
        for (int ai = 0; ai < 2; ++ai)
#pragma unroll
            for (int m = 0; m < 4; ++m) { const int rl = rl0 + ai * HALF + m * 16; const float gw = gwv[ai][m];
                bf16_t* rowp = YB + (size_t)(u.pm * BM + rl) * D + col0;
#pragma unroll
                for (int bj = 0; bj < 2; ++bj) { const f32x4 v0 = acc[ai][bj][m][0] * gw, v1 = acc[ai][bj][m][1] * gw;
                    u32x4 w; w.x = cvt_pk_bf16(v0[0], v0[1]); w.y = cvt_pk_bf16(v0[2], v0[3]); w.z = cvt_pk_bf16(v1[0], v1[1]); w.w = cvt_pk_bf16(v1[2], v1[3]);
                    *(u32x4*)(rowp + bj * HALF) = w; } }
    }
};
struct EpiRes {
    static constexpr bool PERM = true, AFTER_DRAIN = true;
    const float* base; float* out; bf16_t* xb; float* rss;
    __device__ __forceinline__ void fused(f32x4 (&acc)[2][2][4][2], const Unit& u, int wr, int wc, int fr, int fq, PG8_LAS unsigned char* lds, int wid, int lane) const {
        PG8_LAS float* P = (PG8_LAS float*)lds;
        const int col0 = u.pn * BM + wc * 32 + 8 * fq;
#pragma unroll
        for (int ai = 0; ai < 2; ++ai)
#pragma unroll
            for (int m = 0; m < 4; ++m) { const int rl = ai * HALF + wr * 64 + m * 16 + fr; const size_t off = (size_t)(u.pm * BM + rl) * D + col0; float ss = 0.f;
#pragma unroll
                for (int bj = 0; bj < 2; ++bj) { const f32x4 b0 = *(const f32x4*)(base + off + bj * HALF), b1 = *(const f32x4*)(base + off + bj * HALF + 4);
                    const f32x4 x0 = b0 + acc[ai][bj][m][0], x1 = b1 + acc[ai][bj][m][1];
                    *(f32x4*)(out + off + bj * HALF) = x0; *(f32x4*)(out + off + bj * HALF + 4) = x1;
                    u32x4 w; w.x = cvt_pk_bf16(x0[0], x0[1]); w.y = cvt_pk_bf16(x0[2], x0[3]); w.z = cvt_pk_bf16(x1[0], x1[1]); w.w = cvt_pk_bf16(x1[2], x1[3]);
                    *(u32x4*)(xb + off + bj * HALF) = w;
                    ss += (x0[0] * x0[0] + x0[1] * x0[1]) + (x0[2] * x0[2] + x0[3] * x0[3]) + (x1[0] * x1[0] + x1[1] * x1[1]) + (x1[2] * x1[2] + x1[3] * x1[3]); }
                ss += __shfl_xor(ss, 16); ss += __shfl_xor(ss, 32);
                if (fq == 0) P[rl * 4 + wc] = ss;
                asm volatile("" ::: "memory"); }
        asm volatile("s_waitcnt lgkmcnt(0)" ::: "memory"); __builtin_amdgcn_s_barrier(); asm volatile("" ::: "memory");
        const int t = wid * 64 + lane;
        if (t < 256) { const f32x4 p = *(const PG8_LAS f32x4*)(P + t * 4); rss[(size_t)u.pn * T + u.pm * BM + t] = (p[0] + p[1]) + (p[2] + p[3]); }
    }
};

template <class Epi, class Sched, bool ALIGN_EPI, bool SP2>
__device__ __forceinline__ void gemm_phase(PG8_LAS unsigned char* lds, const int K, const Sched& S, const Epi& E) {
    int tid_ = threadIdx.x; asm volatile("" : "+v"(tid_));
    const int tid = tid_, wid = __builtin_amdgcn_readfirstlane(tid >> 6), lane = tid & 63, wr = wid >> 2, wc = wid & 3, fr = lane & 15, fq = lane >> 4;
    const int nt = K / BK;
    unsigned voffA[2], voffB[2]; int stR[2], stC[2];
#pragma unroll
    for (int i = 0; i < 2; ++i) { int R, C; stage_rc(tid * 16 + i * 8192, R, C); const int Rb = Epi::PERM ? ((R & ~31) + perm32(R & 31)) : R;
        voffA[i] = (unsigned)(R * K + C) * 2u; voffB[i] = (unsigned)(Rb * K + C) * 2u; stR[i] = R; stC[i] = C; }
    const size_t kstep = (size_t)(BK * 2);
    const size_t hstep = (size_t)HALF * K * 2;
    const unsigned ldsw = (unsigned)wid * 1024u;
    const int aoff = lds_byte(wr * 64 + fr, fq * 8), boff = lds_byte(wc * 32 + fr, fq * 8);
#define PG8_SA(b, h) (((b) * 2 + (h)) * HTB)
#define PG8_SB(b, h) ((4 + (b) * 2 + (h)) * HTB)
#define PG8_STAGE(bufoff, gbase, voff) do { _Pragma("unroll") for (int _i = 0; _i < 2; ++_i) \
        __builtin_amdgcn_global_load_lds((const unsigned*)((const char*)(gbase) + (voff)[_i]), (PG8_LAS unsigned*)(lds + (bufoff) + ldsw + _i * 8192), 16, 0, 0); } while (0)
#define PG8_STG_A(bufoff, h, kptr, VG) do { if constexpr (Sched::GATHER) { PG8_STAGE(bufoff, kptr, VG[h]); } else { PG8_STAGE(bufoff, (kptr) + (h) * hstep, voffA); } } while (0)
#define PG8_LDA(dst, b, h) do { _Pragma("unroll") for (int m = 0; m < 4; ++m) _Pragma("unroll") for (int k = 0; k < 2; ++k) dst[m][k] = *(const PG8_LAS bf16x8*)(lds + PG8_SA(b, h) + aoff + m * 2048 + k * 1024); } while (0)
#define PG8_LDB(dst, b, h) do { _Pragma("unroll") for (int n = 0; n < 2; ++n) _Pragma("unroll") for (int k = 0; k < 2; ++k) dst[n][k] = *(const PG8_LAS bf16x8*)(lds + PG8_SB(b, h) + boff + n * 2048 + k * 1024); } while (0)
#define PG8_MMA(ai, bj, At, Bt) do { __builtin_amdgcn_s_setprio(1); _Pragma("unroll") for (int m = 0; m < 4; ++m) _Pragma("unroll") for (int n = 0; n < 2; ++n) _Pragma("unroll") for (int k = 0; k < 2; ++k) \
        acc[ai][bj][m][n] = __builtin_amdgcn_mfma_f32_16x16x32_bf16(Bt[n][k], At[m][k], acc[ai][bj][m][n], 0, 0, 0); __builtin_amdgcn_s_setprio(0); } while (0)
#define PG8_WAIT_V(n) asm volatile("s_waitcnt vmcnt(" #n ")" ::: "memory")
#define PG8_WAIT_L(n) asm volatile("s_waitcnt lgkmcnt(" #n ")" ::: "memory")
#define PG8_BAR __builtin_amdgcn_s_barrier()
#define PG8_SCHED __builtin_amdgcn_sched_barrier(0)
    Unit cur, nxt; int ui = 0;
    if (!S.next(0, cur)) return;
    f32x4 acc[2][2][4][2];
#pragma unroll
    for (int a = 0; a < 2; ++a)
#pragma unroll
        for (int b = 0; b < 2; ++b)
#pragma unroll
            for (int m = 0; m < 4; ++m)
#pragma unroll
                for (int n = 0; n < 2; ++n) acc[a][b][m][n] = (f32x4){0.f, 0.f, 0.f, 0.f};
    bf16x8 At[4][2], B0[2][2], B1[2][2];
    unsigned vgc[2][2] = {{0u, 0u}, {0u, 0u}}, vgn[2][2] = {{0u, 0u}, {0u, 0u}};
    const char* cA = S.a_ptr(cur); const char* cB = S.b_ptr(cur);
    if constexpr (Sched::GATHER) { S.a_voff(cur, stR, stC, K, vgc); asm volatile("" : "+v"(vgc[0][0]), "+v"(vgc[0][1]), "+v"(vgc[1][0]), "+v"(vgc[1][1])); }
    if constexpr (SP2) {
        PG8_STAGE(PG8_SB(0, 0), cB, voffB); PG8_STAGE(PG8_SB(0, 1), cB + hstep, voffB); PG8_STG_A(PG8_SA(0, 0), 0, cA, vgc); PG8_STG_A(PG8_SA(0, 1), 1, cA, vgc);
        if (wr == 1) PG8_BAR;
        PG8_WAIT_V(2); PG8_BAR;
        PG8_STAGE(PG8_SB(1, 0), cB + kstep, voffB); PG8_STG_A(PG8_SA(1, 0), 0, cA + kstep, vgc); PG8_STAGE(PG8_SB(1, 1), cB + hstep + kstep, voffB);
        PG8_WAIT_V(6); PG8_BAR;
    } else {
        PG8_STAGE(PG8_SB(0, 0), cB, voffB); PG8_STG_A(PG8_SA(0, 0), 0, cA, vgc); PG8_STAGE(PG8_SB(0, 1), cB + hstep, voffB); PG8_STG_A(PG8_SA(0, 1), 1, cA, vgc);
        if (wr == 1) PG8_BAR;
        PG8_WAIT_V(4); PG8_BAR;
        PG8_STAGE(PG8_SB(1, 0), cB + kstep, voffB); PG8_STG_A(PG8_SA(1, 0), 0, cA + kstep, vgc); PG8_STAGE(PG8_SB(1, 1), cB + hstep + kstep, voffB);
        PG8_WAIT_V(6); PG8_BAR;
    }
    for (;;) {
        const bool has_next = S.next(ui + 1, nxt);
        const char* nA = has_next ? S.a_ptr(nxt) : cA; const char* nB = has_next ? S.b_ptr(nxt) : cB;
        if constexpr (Sched::GATHER) {
            if (has_next) S.a_voff(nxt, stR, stC, K, vgn); else { vgn[0][0] = vgc[0][0]; vgn[0][1] = vgc[0][1]; vgn[1][0] = vgc[1][0]; vgn[1][1] = vgc[1][1]; }
            asm volatile("" : "+v"(vgn[0][0]), "+v"(vgn[0][1]), "+v"(vgn[1][0]), "+v"(vgn[1][1]));
        }
        for (int t = 0; t < nt; t += 2) {
            const bool last = (t == nt - 2);
            const char* a1 = cA + (size_t)(t + 1) * kstep;
            const char* a2 = last ? nA : cA + (size_t)(t + 2) * kstep; const char* b2 = last ? nB : cB + (size_t)(t + 2) * kstep;
            const char* a3 = a2 + kstep; const char* b3 = b2 + kstep;
            unsigned vgx[2][2];
            if constexpr (Sched::GATHER) {
#pragma unroll
                for (int h = 0; h < 2; ++h)
#pragma unroll
                    for (int i = 0; i < 2; ++i) vgx[h][i] = last ? vgn[h][i] : vgc[h][i];
            }
            if constexpr (SP2) {
            PG8_LDB(B0, 0, 0); PG8_LDB(B1, 0, 1); PG8_SCHED; PG8_LDA(At, 0, 0); PG8_STG_A(PG8_SA(1, 1), 1, a1, vgc);
            PG8_WAIT_V(8); PG8_WAIT_L(0); PG8_BAR; PG8_MMA(0, 0, At, B0); PG8_MMA(0, 1, At, B1); PG8_BAR; PG8_SCHED;
            PG8_LDA(At, 0, 1); PG8_STAGE(PG8_SB(0, 0), b2, voffB); PG8_STAGE(PG8_SB(0, 1), b2 + hstep, voffB); PG8_STG_A(PG8_SA(0, 0), 0, a2, vgx);
            PG8_WAIT_V(8); PG8_WAIT_L(0); PG8_BAR; PG8_MMA(1, 0, At, B0); PG8_MMA(1, 1, At, B1); PG8_BAR; PG8_SCHED;
            PG8_LDB(B0, 1, 0); PG8_LDB(B1, 1, 1); PG8_SCHED; PG8_LDA(At, 1, 0); PG8_STG_A(PG8_SA(0, 1), 1, a2, vgx);
            PG8_WAIT_V(8); PG8_WAIT_L(0); PG8_BAR; PG8_MMA(0, 0, At, B0); PG8_MMA(0, 1, At, B1); PG8_BAR; PG8_SCHED;
            PG8_LDA(At, 1, 1); PG8_STAGE(PG8_SB(1, 0), b3, voffB); PG8_STAGE(PG8_SB(1, 1), b3 + hstep, voffB); PG8_STG_A(PG8_SA(1, 0), 0, a3, vgx);
            PG8_WAIT_V(8); PG8_WAIT_L(0); PG8_BAR; PG8_MMA(1, 0, At, B0); PG8_MMA(1, 1, At, B1); PG8_BAR; PG8_SCHED;
            } else {
            PG8_LDB(B0, 0, 0); PG8_SCHED; PG8_LDA(At, 0, 0); PG8_STG_A(PG8_SA(1, 1), 1, a1, vgc);
            PG8_WAIT_L(8); PG8_BAR; PG8_WAIT_L(0); PG8_MMA(0, 0, At, B0); PG8_BAR; PG8_SCHED;
            PG8_LDB(B1, 0, 1); PG8_STAGE(PG8_SB(0, 0), b2, voffB);
            PG8_BAR; PG8_WAIT_L(0); PG8_MMA(0, 1, At, B1); PG8_BAR;
            PG8_LDA(At, 0, 1); PG8_STG_A(PG8_SA(0, 0), 0, a2, vgx);
            PG8_BAR; PG8_WAIT_L(0); PG8_MMA(1, 0, At, B0); PG8_BAR; PG8_SCHED;
            PG8_STAGE(PG8_SB(0, 1), b2 + hstep, voffB);
            PG8_WAIT_V(6); PG8_BAR; PG8_MMA(1, 1, At, B1); PG8_BAR;
            PG8_LDB(B0, 1, 0); PG8_SCHED; PG8_LDA(At, 1, 0); PG8_STG_A(PG8_SA(0, 1), 1, a2, vgx);
            PG8_WAIT_L(8); PG8_BAR; PG8_WAIT_L(0); PG8_MMA(0, 0, At, B0); PG8_BAR; PG8_SCHED;
            PG8_LDB(B1, 1, 1); PG8_STAGE(PG8_SB(1, 0), b3, voffB);
            PG8_BAR; PG8_WAIT_L(0); PG8_MMA(0, 1, At, B1); PG8_BAR;
            PG8_LDA(At, 1, 1); PG8_STG_A(PG8_SA(1, 0), 0, a3, vgx);
            PG8_BAR; PG8_WAIT_L(0); PG8_MMA(1, 0, At, B0); PG8_BAR; PG8_SCHED;
            PG8_STAGE(PG8_SB(1, 1), b3 + hstep, voffB);
            PG8_WAIT_V(6); PG8_BAR; PG8_MMA(1, 1, At, B1); PG8_BAR;
            }
        }
        if constexpr (ALIGN_EPI) { if (wr == 0) PG8_BAR; }
        if constexpr (!Epi::AFTER_DRAIN) { E(acc, cur, wr, wc, fr, fq); }
        if (!has_next) break;
#pragma unroll
        for (int a = 0; a < 2; ++a)
#pragma unroll
            for (int b = 0; b < 2; ++b)
#pragma unroll
                for (int m = 0; m < 4; ++m)
#pragma unroll
                    for (int n = 0; n < 2; ++n) acc[a][b][m][n] = (f32x4){0.f, 0.f, 0.f, 0.f};
        cur = nxt; cA = nA; cB = nB; ++ui;
        if constexpr (Sched::GATHER) { vgc[0][0] = vgn[0][0]; vgc[0][1] = vgn[0][1]; vgc[1][0] = vgn[1][0]; vgc[1][1] = vgn[1][1]; }
        if constexpr (ALIGN_EPI) { if (wr == 1) PG8_BAR; }
    }
    PG8_WAIT_V(0);
    if constexpr (!ALIGN_EPI) { if (wr == 0) PG8_BAR; }
    PG8_BAR;
    if constexpr (Epi::AFTER_DRAIN) { E.fused(acc, cur, wr, wc, fr, fq, lds, wid, lane); }
#undef PG8_SA
#undef PG8_SB
#undef PG8_STAGE
#undef PG8_STG_A
#undef PG8_LDA
#undef PG8_LDB
#undef PG8_MMA
#undef PG8_WAIT_V
#undef PG8_WAIT_L
#undef PG8_BAR
#undef PG8_SCHED
}
}

#define XB_TMO      128
#define XB_XCNT(j)  (256  + 64 * (j))
#define XB_XSUB(j)  (1280 + 64 * (j))
#define XB_XGEN(j)  (2304 + 64 * (j))
#define XB_TOP      3328
#define XB_TOPGEN   3392
#define XCD_BAR_WORDS 3456
#define XB_SPIN_CAP (1u << 18)
__device__ __forceinline__ unsigned xb_ld(unsigned* p)              { return __hip_atomic_load(p, __ATOMIC_RELAXED, __HIP_MEMORY_SCOPE_AGENT); }
__device__ __forceinline__ unsigned xb_add(unsigned* p, unsigned v) { return __hip_atomic_fetch_add(p, v, __ATOMIC_RELAXED, __HIP_MEMORY_SCOPE_AGENT); }
__device__ __forceinline__ unsigned xb_xcc_id() { return (unsigned)__builtin_amdgcn_s_getreg((3 << 11) | 20) & 0xFu; }
#define XB_SPIN(cond, bar) do { unsigned _sp = 0; while (cond) { __builtin_amdgcn_s_sleep(1); \
    if ((++_sp & 255u) == 0u) { if (xb_ld(&(bar)[XB_TMO])) break; if (_sp > XB_SPIN_CAP) { atomicAdd(&(bar)[XB_TMO], 1u); break; } } } } while (0)
struct XcdBarrier { unsigned* bar; unsigned x; volatile LAS unsigned* st; };
__device__ __forceinline__ XcdBarrier xcd_barrier_post(unsigned* bar, volatile LAS unsigned* st) {
    XcdBarrier b; b.bar = bar; b.x = xb_xcc_id(); b.st = st;
    if (threadIdx.x == 0) (void)xb_add(&bar[XB_XCNT(b.x)], 1u);
    return b;
}
__device__ __forceinline__ void xcd_barrier_complete(unsigned* bar, unsigned x, unsigned& nloc, unsigned& nx) {
    const unsigned G = gridDim.x * gridDim.y * gridDim.z;
    unsigned sum, cnt, mine, sp = 0u;
    for (;;) {
        sum = 0u; cnt = 0u; mine = 0u;
#pragma unroll
        for (unsigned j = 0; j < 16; ++j) { const unsigned c = xb_ld(&bar[XB_XCNT(j)]); sum += c; cnt += (c > 0u) ? 1u : 0u; mine = (j == x) ? c : mine; }
        if (sum == G) break;
        __builtin_amdgcn_s_sleep(1);
        if ((++sp & 255u) == 0u) { if (xb_ld(&bar[XB_TMO])) break; if (sp > XB_SPIN_CAP) { atomicAdd(&bar[XB_TMO], 1u); break; } }
    }
    nloc = mine > 0u ? mine : 1u; nx = cnt > 0u ? cnt : 1u;
}
__device__ __forceinline__ void xcd_barrier(const XcdBarrier& b) {
    asm volatile("s_waitcnt vmcnt(0)" ::: "memory");
    __syncthreads();
    if (threadIdx.x == 0) {
        unsigned* bar = b.bar;
        __builtin_amdgcn_s_waitcnt(0);
        unsigned nloc = b.st[0], nx = b.st[1];
        if (nloc == 0u) { xcd_barrier_complete(bar, b.x, nloc, nx); b.st[0] = nloc; b.st[1] = nx; }
        const unsigned old = xb_add(&bar[XB_XSUB(b.x)], 1u);
        const unsigned gen = old / nloc;
        if (old + 1u == (gen + 1u) * nloc) {
            __builtin_amdgcn_fence(__ATOMIC_RELEASE, "agent");
            asm volatile("s_waitcnt vmcnt(0)" ::: "memory");
            const unsigned og = xb_add(&bar[XB_TOP], 1u);
            const unsigned tg = og / nx;
            if (og + 1u == (tg + 1u) * nx) xb_add(&bar[XB_TOPGEN], 1u);
            else XB_SPIN(xb_ld(&bar[XB_TOPGEN]) == tg, bar);
            __builtin_amdgcn_fence(__ATOMIC_ACQUIRE, "agent");
            xb_add(&bar[XB_XGEN(b.x)], 1u);
            asm volatile("s_waitcnt vmcnt(0)" ::: "memory");
        } else {
            XB_SPIN(xb_ld(&bar[XB_XGEN(b.x)]) == gen, bar);
            __builtin_amdgcn_fence(__ATOMIC_ACQUIRE, "agent");
            asm volatile("s_waitcnt vmcnt(0)" ::: "memory");
        }
    }
    __syncthreads();
}

typedef __attribute__((address_space(4))) const char* karg_ptr;
struct Frame {
    LAS unsigned char* lds;
    volatile LAS unsigned* MISC;
    int tid, lane, wave, vcu, G;
    karg_ptr ka;
    __device__ __forceinline__ const float* inp(int i) const { return *(const float* const __attribute__((address_space(4)))*)(ka + 8 * i); }
    __device__ __forceinline__ float* outp() const { return *(float* const __attribute__((address_space(4)))*)(ka + 8 * 17); }
    __device__ __forceinline__ unsigned char* wsp() const { return *(unsigned char* const __attribute__((address_space(4)))*)(ka + 8 * 18); }
    __device__ __forceinline__ gu32* ctl() const { return (gu32*)(wsp() + WS_CTL); }
    __device__ __forceinline__ bf16_t* XB() const { return (bf16_t*)(wsp() + WS_XB); }
    __device__ __forceinline__ bf16_t* Z() const { return (bf16_t*)(wsp() + WS_Z); }
    __device__ __forceinline__ bf16_t* Y() const { return (bf16_t*)(wsp() + WS_Y); }
    __device__ __forceinline__ float* rss() const { return (float*)(wsp() + WS_RSS); }
    __device__ __forceinline__ float* rinvtok() const { return (float*)(wsp() + WS_RINV); }
    __device__ __forceinline__ float* kpart() const { return (float*)(wsp() + WS_KPART); }
    __device__ __forceinline__ float* grow() const { return (float*)(wsp() + WS_GROW); }
    __device__ __forceinline__ int* tokof() const { return (int*)(wsp() + WS_TOKOF); }
    __device__ __forceinline__ int* tslot() const { return (int*)(wsp() + WS_TSLOT); }
};
enum { IN_X = 0, IN_GMIX, IN_WIN, IN_SGULN, IN_SGUW, IN_SGUB, IN_CONVW, IN_WOUT, IN_GFFN, IN_DWG, IN_DWU, IN_DWD, IN_ROUTER, IN_MWG, IN_MWU, IN_MWD, IN_GFINAL };

__device__ __forceinline__ void p0_item(const float* W, int N, const float* g, bf16_t* WT, int K, int drow0, int k0, int n0, LAS float* scr, int lane) {
#pragma unroll 8
    for (int i = 0; i < 32; ++i) { const int kk = 2 * i + (lane >> 5); scr[kk * 33 + (lane & 31)] = W[(size_t)(k0 + kk) * N + n0 + (lane & 31)]; }
    LDS_WAIT(); asm volatile("" ::: "memory");
    const int c = lane & 7;
    f32x4 g0 = (f32x4){1.f, 1.f, 1.f, 1.f}, g1 = g0;
    if (g) { g0 = *(const f32x4*)(g + k0 + 8 * c); g1 = *(const f32x4*)(g + k0 + 8 * c + 4); }
#pragma unroll
    for (int j = 0; j < 4; ++j) { const int n = (lane >> 3) + 8 * j; const LAS float* s = scr + (8 * c) * 33 + n;
        u32x4 o; o.x = cvt_pk_bf16(s[0 * 33] * g0[0], s[1 * 33] * g0[1]); o.y = cvt_pk_bf16(s[2 * 33] * g0[2], s[3 * 33] * g0[3]);
        o.z = cvt_pk_bf16(s[4 * 33] * g1[0], s[5 * 33] * g1[1]); o.w = cvt_pk_bf16(s[6 * 33] * g1[2], s[7 * 33] * g1[3]);
        *(u32x4*)(WT + (size_t)(drow0 + n) * K + k0 + 8 * c) = o; }
    LDS_WAIT(); asm volatile("" ::: "memory");
}
__device__ __forceinline__ void p0_prologue(Frame& F) {
    LAS float* scr = (LAS float*)(F.lds + F.wave * 16384);
    const int gw = F.vcu * NWAVES + F.wave, NGW = F.G * NWAVES;
    constexpr int IT_IN = 16 * 88, IT_OUT = 16 * 32, IT_GU = 16 * 88, IT_DN = 44 * 32;
    constexpr int NA = 2 * IT_IN, NBB = 2 * IT_OUT, NC = 18 * IT_GU, ND = 9 * IT_DN, NITEMS = NA + NBB + NC + ND;
    unsigned char* ws = F.wsp();
    for (int it = gw; it < NITEMS; it += NGW) {
        int r = it;
        if (r < NA) { const int l = r / IT_IN; r %= IT_IN; const int kb = r / 88, nb = r % 88;
            p0_item(F.inp(IN_WIN) + (size_t)l * D * INC, INC, F.inp(IN_GMIX) + l * D, (bf16_t*)(ws + WS_WIN) + (size_t)l * INC * D, D, 32 * nb, 64 * kb, 32 * nb, scr, F.lane); continue; }
        r -= NA;
        if (r < NBB) { const int l = r / IT_OUT; r %= IT_OUT; const int kb = r / 32, nb = r % 32;
            p0_item(F.inp(IN_WOUT) + (size_t)l * D * D, D, nullptr, (bf16_t*)(ws + WS_WOUT) + (size_t)l * D * D, D, 32 * nb, 64 * kb, 32 * nb, scr, F.lane); continue; }
        r -= NBB;
        if (r < NC) { const int mm = r / IT_GU; r %= IT_GU; const int set = mm >> 1, up = mm & 1; const int kb = r / 88, nb = r % 88, n0 = 32 * nb;
            const float* W = set == 0 ? (up ? F.inp(IN_DWU) : F.inp(IN_DWG)) : ((up ? F.inp(IN_MWU) : F.inp(IN_MWG)) + (size_t)(set - 1) * D * FF);
            bf16_t* WT = set == 0 ? (bf16_t*)(ws + WS_WGU0) : (bf16_t*)(ws + WS_MWGU) + (size_t)(set - 1) * GU * D;
            p0_item(W, FF, F.inp(IN_GFFN) + (set == 0 ? 0 : D), WT, D, (n0 >> 7) * 256 + up * 128 + (n0 & 127), 64 * kb, n0, scr, F.lane); continue; }
        r -= NC;
        { const int mm = r / IT_DN; r %= IT_DN; const int kb = r / 32, nb = r % 32;
            const float* W = mm == 0 ? F.inp(IN_DWD) : F.inp(IN_MWD) + (size_t)(mm - 1) * FF * D;
            bf16_t* WT = mm == 0 ? (bf16_t*)(ws + WS_WDN0) : (bf16_t*)(ws + WS_MWDN) + (size_t)(mm - 1) * D * FF;
            p0_item(W, D, nullptr, WT, FF, 32 * nb, 64 * kb, 32 * nb, scr, F.lane); }
    }
    const float* x = F.inp(IN_X);
    for (int m = gw; m < T; m += NGW) {
        const f32x4* xr = (const f32x4*)(x + (size_t)m * D) + F.lane; float s = 0.f; u32x2* o8 = (u32x2*)(F.XB() + (size_t)m * D) + F.lane;
#pragma unroll
        for (int j = 0; j < 4; ++j) { const f32x4 v = xr[64 * j]; s += (v[0] * v[0] + v[1] * v[1]) + (v[2] * v[2] + v[3] * v[3]); u32x2 w; w.x = cvt_pk_bf16(v[0], v[1]); w.y = cvt_pk_bf16(v[2], v[3]); o8[64 * j] = w; }
        s = wave_sum(s);
        if (F.lane < 4) F.rss()[(size_t)F.lane * T + m] = F.lane == 0 ? s : 0.f;
    }
}

__device__ __forceinline__ void attn_simple_unit(Frame& F, int mode, int b, int h, int qb) {
    LAS float* Ks = (LAS float*)(F.lds);
    LAS float* Vs = Ks + 4096;
    LAS float* ksm = Vs + 4096;
    const int tid = F.tid, row = tid & 255, dh = tid >> 8;
    const int qoff = mode ? 2048 : 0, ycol = mode ? 768 : 0;
    const int tq = qb * 256 + row;
    const size_t tok = (size_t)b * SEQ + tq;
    float q[64];
    { const u32x4* qp = (const u32x4*)(F.Z() + tok * INC + qoff + h * 64);
#pragma unroll
      for (int i = 0; i < 8; ++i) { const u32x4 w = qp[i]; q[8 * i + 0] = bf_lo(w.x); q[8 * i + 1] = bf_hi(w.x); q[8 * i + 2] = bf_lo(w.y); q[8 * i + 3] = bf_hi(w.y); q[8 * i + 4] = bf_lo(w.z); q[8 * i + 5] = bf_hi(w.z); q[8 * i + 6] = bf_lo(w.w); q[8 * i + 7] = bf_hi(w.w); } }
    unsigned sel = 0u;
    __syncthreads();
    if (mode == 0) {
        { const int j = tid >> 6, d = tid & 63; float v = 0.f; if (j < qb) { const float* kp = F.kpart() + ((size_t)(b * 8 + j) * 2) * 256 + h * 64 + d; v = kp[0] + kp[256]; } ksm[tid] = v; }
        __syncthreads();
        float b0 = -INFINITY, b1 = -INFINITY, b2 = -INFINITY; int i0 = -1, i1 = -1, i2 = -1;
#pragma unroll 1
        for (int j = 0; j < qb; ++j) { float a0 = 0.f, a1 = 0.f, a2 = 0.f, a3 = 0.f; const LAS float* kj = ksm + j * 64;
#pragma unroll
            for (int d = 0; d < 64; d += 4) { const f32x4 kv = *(const LAS f32x4*)(kj + d); a0 += q[d] * kv[0]; a1 += q[d + 1] * kv[1]; a2 += q[d + 2] * kv[2]; a3 += q[d + 3] * kv[3]; }
            const float a = (a0 + a1) + (a2 + a3);
            if (a > b0) { b2 = b1; i2 = i1; b1 = b0; i1 = i0; b0 = a; i0 = j; } else if (a > b1) { b2 = b1; i2 = i1; b1 = a; i1 = j; } else if (a > b2) { b2 = a; i2 = j; } }
        if (i0 >= 0) sel |= 1u << i0; if (i1 >= 0) sel |= 1u << i1; if (i2 >= 0) sel |= 1u << i2;
    }
    float mx = -INFINITY, l = 0.f; float o[32];
#pragma unroll
    for (int d = 0; d < 32; ++d) o[d] = 0.f;
    const int ntl = 4 * (qb + 1);
#pragma unroll 1
    for (int tl = 0; tl < ntl; ++tl) {
        __syncthreads();
        { const int r = tid >> 3, ch = tid & 7; const bf16_t* kr = F.Z() + ((size_t)b * SEQ + tl * 64 + r) * INC + qoff + h * 64 + ch * 8;
          const u32x4 kw = *(const u32x4*)(kr + 256), vw = *(const u32x4*)(kr + 512);
          *(LAS f32x4*)(Ks + r * 64 + ch * 8) = (f32x4){bf_lo(kw.x), bf_hi(kw.x), bf_lo(kw.y), bf_hi(kw.y)}; *(LAS f32x4*)(Ks + r * 64 + ch * 8 + 4) = (f32x4){bf_lo(kw.z), bf_hi(kw.z), bf_lo(kw.w), bf_hi(kw.w)};
          *(LAS f32x4*)(Vs + r * 64 + ch * 8) = (f32x4){bf_lo(vw.x), bf_hi(vw.x), bf_lo(vw.y), bf_hi(vw.y)}; *(LAS f32x4*)(Vs + r * 64 + ch * 8 + 4) = (f32x4){bf_lo(vw.z), bf_hi(vw.z), bf_lo(vw.w), bf_hi(vw.w)}; }
        __syncthreads();
        const int jblk = tl >> 2;
        const bool tile_on = (mode != 0) || (jblk == qb) || ((sel >> jblk) & 1u);
#pragma unroll 1
        for (int key = 0; key < 64; ++key) {
            const int dist = tq - (tl * 64 + key);
            float bias = 0.f; bool valid;
            if (mode == 0) valid = tile_on && (jblk != qb || dist >= 0);
            else { int c = 0; if (dist >= 0) c = (dist <= 128 ? 1 : 0) + ((((dist & 3) == 0) && dist <= 512) ? 1 : 0) + (((dist & 15) == 0) ? 1 : 0);
                   valid = c > 0; bias = c == 3 ? 1.5849625007211562f : (c == 2 ? 1.f : 0.f); }
            if (valid) {
                const LAS float* kr = Ks + key * 64; float s0 = bias, s1 = 0.f, s2 = 0.f, s3 = 0.f;
#pragma unroll
                for (int d = 0; d < 64; d += 4) { const f32x4 kv = *(const LAS f32x4*)(kr + d); s0 += q[d] * kv[0]; s1 += q[d + 1] * kv[1]; s2 += q[d + 2] * kv[2]; s3 += q[d + 3] * kv[3]; }
                const float s = (s0 + s1) + (s2 + s3);
                if (s > mx) { const float a = fast_exp2(mx - s); l *= a;
#pragma unroll
                    for (int d = 0; d < 32; ++d) o[d] *= a;
                    mx = s; }
                const float p = fast_exp2(s - mx); l += p; const LAS float* vr = Vs + key * 64 + dh * 32;
#pragma unroll
                for (int d = 0; d < 32; d += 4) { const f32x4 vv = *(const LAS f32x4*)(vr + d); o[d] += p * vv[0]; o[d + 1] += p * vv[1]; o[d + 2] += p * vv[2]; o[d + 3] += p * vv[3]; }
            }
        }
    }
    { const float inv = 1.f / l;
      u32x4* yp = (u32x4*)(F.Y() + tok * D + ycol + h * 64 + dh * 32);
#pragma unroll
      for (int i = 0; i < 4; ++i) { u32x4 w; w.x = cvt_pk_bf16(o[8 * i] * inv, o[8 * i + 1] * inv); w.y = cvt_pk_bf16(o[8 * i + 2] * inv, o[8 * i + 3] * inv); w.z = cvt_pk_bf16(o[8 * i + 4] * inv, o[8 * i + 5] * inv); w.w = cvt_pk_bf16(o[8 * i + 6] * inv, o[8 * i + 7] * inv); yp[i] = w; } }
    __syncthreads();
}
__device__ __forceinline__ void sgu_simple_item(Frame& F, int l, int item) {
    LAS float* vn = (LAS float*)(F.lds);
    const int tok0 = item * 128;
    const float* lng = F.inp(IN_SGULN) + l * 256;
    __syncthreads();
    for (int t = F.wave; t < 128; t += NWAVES) {
        const bf16_t* zr = F.Z() + (size_t)(tok0 + t) * INC + 1024 + 4 * F.lane; const u32x2 w = *(const u32x2*)zr;
        float v[4] = {gelu_tanh(bf_lo(w.x)), gelu_tanh(bf_hi(w.x)), gelu_tanh(bf_lo(w.y)), gelu_tanh(bf_hi(w.y))};
        const float mean = wave_sum((v[0] + v[1]) + (v[2] + v[3])) * (1.f / 256.f);
        float s2 = 0.f;
#pragma unroll
        for (int e = 0; e < 4; ++e) { v[e] -= mean; s2 += v[e] * v[e]; }
        const float rstd = __builtin_amdgcn_rsqf(wave_sum(s2) * (1.f / 256.f) + LN_EPS);
        const f32x4 gg = *(const f32x4*)(lng + 4 * F.lane);
        *(LAS f32x4*)(vn + t * 256 + 4 * F.lane) = (f32x4){v[0] * rstd * gg[0], v[1] * rstd * gg[1], v[2] * rstd * gg[2], v[3] * rstd * gg[3]};
    }
    __syncthreads();
    const int c = F.tid & 255, th = F.tid >> 8, g = c >> 6;
    const float* Wg = F.inp(IN_SGUW) + ((size_t)l * 4 + g) * 128 * 128;
    const float* bs = F.inp(IN_SGUB) + ((size_t)l * 4 + g) * 128;
    for (int tt = 0; tt < 64; ++tt) {
        const int t = th * 64 + tt; const float* wrow = Wg + t * 128; float a = 0.f;
        for (int s = 0; s <= t; ++s) a += wrow[s] * vn[s * 256 + c];
        const size_t tok = (size_t)tok0 + t;
        const float u = gelu_tanh(bf_lo((unsigned)F.Z()[tok * INC + 768 + c]));
        const float y = u * (a + bs[t]);
        F.Y()[tok * D + 256 + c] = (bf16_t)(cvt_pk_bf16(y, 0.f) & 0xffffu);
    }
    __syncthreads();
}
__device__ __forceinline__ void conv_simple_item(Frame& F, int l, int item) {
    const int c = F.tid & 255, th = F.tid >> 8; const int tok0 = item * 64 + th * 32;
    const float* cw = F.inp(IN_CONVW) + (size_t)l * 3 * 256;
    const float w0 = cw[c], w1 = cw[256 + c], w2 = cw[512 + c];
    float zm2 = 0.f, zm1 = 0.f;
    const int p0 = tok0 & (SEQ - 1);
    if (p0 >= 2) { const bf16_t* z = F.Z() + (size_t)(tok0 - 2) * INC; zm2 = bf_lo((unsigned)z[1536 + c]) * bf_lo((unsigned)z[1792 + c]); }
    if (p0 >= 1) { const bf16_t* z = F.Z() + (size_t)(tok0 - 1) * INC; zm1 = bf_lo((unsigned)z[1536 + c]) * bf_lo((unsigned)z[1792 + c]); }
    for (int t = 0; t < 32; ++t) {
        const bf16_t* z = F.Z() + (size_t)(tok0 + t) * INC;
        const float zc = bf_lo((unsigned)z[1536 + c]) * bf_lo((unsigned)z[1792 + c]);
        const float y = bf_lo((unsigned)z[1280 + c]) * (w0 * zm2 + w1 * zm1 + w2 * zc);
        F.Y()[(size_t)(tok0 + t) * D + 512 + c] = (bf16_t)(cvt_pk_bf16(y, 0.f) & 0xffffu);
        zm2 = zm1; zm1 = zc;
    }
}
#ifndef MIXP
#define MIXP 7
#endif
__device__ __forceinline__ void mixers_phase(Frame& F, int l) {
    if (MIXP & 1) for (int v = F.vcu; v < 256; v += F.G) {
        const int mode = v >> 7, bh = (v & 127) >> 2, s = v & 3;
        attn_simple_unit(F, mode, bh >> 2, bh & 3, s);
        attn_simple_unit(F, mode, bh >> 2, bh & 3, 7 - s);
    }
    if (MIXP & 2) for (int it = F.vcu; it < 128; it += F.G) sgu_simple_item(F, l, it);
    if (MIXP & 4) for (int it = F.vcu; it < 256; it += F.G) conv_simple_item(F, l, it);
}

__device__ __forceinline__ void router_phase(Frame& F) {
    LAS int* pe = (LAS int*)(F.lds);
    LAS float* pg = (LAS float*)(F.lds + 512);
    const float* x1 = F.outp(); const float* gf = F.inp(IN_GFFN) + D; const float* rw = F.inp(IN_ROUTER);
    f32x4 w0[16], w1[16];
#pragma unroll
    for (int j = 0; j < 4; ++j)
#pragma unroll
        for (int e = 0; e < 4; ++e) { const int k = 4 * F.lane + 256 * j + e; const float g = gf[k]; w0[4 * j + e] = *(const f32x4*)(rw + (size_t)k * 8) * g; w1[4 * j + e] = *(const f32x4*)(rw + (size_t)k * 8 + 4) * g; }
    for (int grp = F.vcu; grp < T / 64; grp += F.G) {
        __syncthreads();
        for (int i = 0; i < 8; ++i) {
            const int tl = F.wave * 8 + i, tok = grp * 64 + tl;
            const f32x4* xr = (const f32x4*)(x1 + (size_t)tok * D) + F.lane;
            f32x4 a0 = (f32x4){0.f, 0.f, 0.f, 0.f}, a1 = a0; float ss = 0.f;
#pragma unroll
            for (int j = 0; j < 4; ++j) { const f32x4 v = xr[64 * j]; ss += (v[0] * v[0] + v[1] * v[1]) + (v[2] * v[2] + v[3] * v[3]);
#pragma unroll
                for (int e = 0; e < 4; ++e) { a0 += w0[4 * j + e] * v[e]; a1 += w1[4 * j + e] * v[e]; } }
            ss = wave_sum(ss); const float ri = __builtin_amdgcn_rsqf(ss * (1.f / D) + RMS_EPS);
            float lg[8];
#pragma unroll
            for (int e = 0; e < 4; ++e) { lg[e] = wave_sum(a0[e]) * ri; lg[4 + e] = wave_sum(a1[e]) * ri; }
            int e0 = 0; float v0 = lg[0];
#pragma unroll
            for (int e = 1; e < 8; ++e) if (lg[e] > v0) { v0 = lg[e]; e0 = e; }
            int e1 = -1; float v1 = -INFINITY;
#pragma unroll
            for (int e = 0; e < 8; ++e) if (e != e0 && lg[e] > v1) { v1 = lg[e]; e1 = e; }
            const float g0 = 1.f / (1.f + __expf(v1 - v0)), g1 = 1.f - g0;
            if (F.lane == 0) { pe[2 * tl] = e0; pe[2 * tl + 1] = e1; pg[2 * tl] = g0; pg[2 * tl + 1] = g1; F.rinvtok()[tok] = ri; }
        }
        __syncthreads();
        if (F.wave == 0) {
            const int elo = pe[F.lane], ehi = pe[64 + F.lane]; const float glo = pg[F.lane], ghi = pg[64 + F.lane];
            const unsigned long long ltm = (1ull << F.lane) - 1ull;
            int rlo = 0, rhi = 0, mycnt = 0;
#pragma unroll
            for (int e = 0; e < 8; ++e) { const unsigned long long mlo = __ballot(elo == e), mhi = __ballot(ehi == e); const int clo = __popcll(mlo);
                if (elo == e) rlo = __popcll(mlo & ltm); if (ehi == e) rhi = clo + __popcll(mhi & ltm); if (F.lane == e) mycnt = clo + __popcll(mhi); }
            int mybase = 0;
            if (F.lane < 8) mybase = (int)__hip_atomic_fetch_add((unsigned*)(F.ctl() + CW_CNT + F.lane), (unsigned)mycnt, RLX_AGENT);
            const int blo = __shfl(mybase, elo), bhi = __shfl(mybase, ehi);
            const int slo = elo * 16384 + blo + rlo, shi = ehi * 16384 + bhi + rhi;
            const int toklo = grp * 64 + (F.lane >> 1), tokhi = grp * 64 + 32 + (F.lane >> 1);
            F.tokof()[slo] = toklo; F.grow()[slo] = glo; F.tslot()[2 * toklo + (F.lane & 1)] = slo;
            F.tokof()[shi] = tokhi; F.grow()[shi] = ghi; F.tslot()[2 * tokhi + (F.lane & 1)] = shi;
        }
    }
}
__device__ __forceinline__ void moe_counts(Frame& F, int (&pb)[8], int (&cn)[8], int& nrb) {
    int acc = 0;
#pragma unroll
    for (int e = 0; e < 8; ++e) { const int c = (int)__builtin_amdgcn_readfirstlane(__hip_atomic_load((unsigned*)(F.ctl() + CW_CNT + e), RLX_AGENT)); cn[e] = c; pb[e] = acc; acc += (c + 255) >> 8; }
    nrb = acc;
}
__device__ __forceinline__ void final_phase(Frame& F) {
    int pb[8], cn[8], nrb; moe_counts(F, pb, cn, nrb);
    const bf16_t* YB = (const bf16_t*)(F.wsp() + WS_YB); const float* gfin = F.inp(IN_GFINAL);
    const int gw = F.vcu * NWAVES + F.wave, NGW = F.G * NWAVES;
    for (int m = gw; m < T; m += NGW) {
        const int s0 = F.tslot()[2 * m], s1 = F.tslot()[2 * m + 1];
        int r0 = s0 & 16383, r1 = s1 & 16383; const int e0 = s0 >> 14, e1 = s1 >> 14;
#pragma unroll
        for (int e = 0; e < 8; ++e) { if (e0 == e) r0 += pb[e] * 256; if (e1 == e) r1 += pb[e] * 256; }
        f32x4* xr = (f32x4*)(F.outp() + (size_t)m * D) + F.lane;
        const u32x2* y0 = (const u32x2*)(YB + (size_t)r0 * D) + F.lane; const u32x2* y1 = (const u32x2*)(YB + (size_t)r1 * D) + F.lane;
        f32x4 v[4]; float ss = 0.f;
#pragma unroll
        for (int j = 0; j < 4; ++j) { const u32x2 a = y0[64 * j], b = y1[64 * j]; f32x4 t = xr[64 * j];
            t[0] += bf_lo(a.x) + bf_lo(b.x); t[1] += bf_hi(a.x) + bf_hi(b.x); t[2] += bf_lo(a.y) + bf_lo(b.y); t[3] += bf_hi(a.y) + bf_hi(b.y);
            v[j] = t; ss += (t[0] * t[0] + t[1] * t[1]) + (t[2] * t[2] + t[3] * t[3]); }
        const float ri = __builtin_amdgcn_rsqf(wave_sum(ss) * (1.f / D) + RMS_EPS);
#pragma unroll
        for (int j = 0; j < 4; ++j) { const f32x4 g = *((const f32x4*)gfin + F.lane + 64 * j); xr[64 * j] = v[j] * ri * g; }
    }
}

__device__ __forceinline__ void refresh(Frame& F) { int t = threadIdx.x; asm volatile("" : "+v"(t)); F.tid = t; F.lane = t & 63; }
__device__ __forceinline__ int opaque_s(int v) { asm volatile("" : "+s"(v)); return v; }
struct Args { const float* in[17]; float* out; unsigned char* ws; int ph_lo, ph_hi; };
__global__ void __launch_bounds__(NWAVES * 64, 2) trunk_fwd(Args args) {
    extern __shared__ __attribute__((aligned(16))) unsigned char lds[];
    Frame F;
    F.lds = (LAS unsigned char*)lds;
    F.MISC = (volatile LAS unsigned*)(F.lds + MISC_OFF);
    F.tid = threadIdx.x; F.lane = F.tid & 63; F.wave = __builtin_amdgcn_readfirstlane(F.tid >> 6);
    F.G = gridDim.x; { const int bx = blockIdx.x; F.vcu = (F.G % 8 == 0) ? (bx % 8) * (F.G / 8) + bx / 8 : bx; }
    F.ka = (karg_ptr)__builtin_amdgcn_kernarg_segment_ptr();
    for (int u = F.tid; u < (LDS_BYTES - LDSCTL_OFF) / 4; u += NWAVES * 64) ((LAS unsigned*)(F.lds + LDSCTL_OFF))[u] = 0u;
    __syncthreads();
    XcdBarrier bar; bar.bar = (unsigned*)(F.ctl() + CW_BAR); bar.x = 0; bar.st = nullptr;
    if (MK_N_LAUNCHES == 1) bar = xcd_barrier_post((unsigned*)(F.ctl() + CW_BAR), F.MISC + 8);
#define GRID_BAR() do { if (MK_N_LAUNCHES == 1) xcd_barrier(bar); } while (0)
    const int lo = *(const int __attribute__((address_space(4)))*)(F.ka + 152), hi = *(const int __attribute__((address_space(4)))*)(F.ka + 156);
    (void)args;
#define IN(k) (lo <= (k) && (k) < hi)
#define BOTH(k) (IN(k) && IN((k) + 1))
    PG8_LAS unsigned char* glds = (PG8_LAS unsigned char*)F.lds;
    const int bx = (int)blockIdx.x;

    asm volatile("; MARK P0");
    if (PHC(0) && IN(0)) { refresh(F); p0_prologue(F); if (BOTH(0)) GRID_BAR(); }
    for (int l = 0; l < 2; ++l) {
        const int pbase = 1 + 5 * l;
        asm volatile("; MARK IN_GEMM");
        if (PHC(1) && IN(pbase)) {
            pg8::StaticOrder S; S.init(F.XB(), (const bf16_t*)(F.wsp() + WS_WIN) + (size_t)l * INC * D, T, INC, D, F.G, opaque_s(bx));
            pg8::EpiIn E{F.Z(), F.rss(), F.kpart()};
            pg8::gemm_phase<pg8::EpiIn, pg8::StaticOrder, true, true>(glds, D, S, E);
            if (BOTH(pbase)) GRID_BAR();
        }
        asm volatile("; MARK MIXERS");
        if (PHC(2) && IN(pbase + 1)) { refresh(F); mixers_phase(F, l); if (BOTH(pbase + 1)) GRID_BAR(); }
        asm volatile("; MARK OUT_GEMM");
        if (PHC(3) && IN(pbase + 2)) {
            pg8::StaticOrder S; S.init(F.Y(), (const bf16_t*)(F.wsp() + WS_WOUT) + (size_t)l * D * D, T, D, D, F.G, opaque_s(bx));
            pg8::EpiRes E{l == 0 ? F.inp(IN_X) : F.outp(), F.outp(), F.XB(), F.rss()};
            if (F.G == 256) pg8::gemm_phase<pg8::EpiRes, pg8::StaticOrder, false, true>(glds, D, S, E);
            if (BOTH(pbase + 2)) GRID_BAR();
        }
        if (l == 0) {
            asm volatile("; MARK DENSE_GU");
            if (PHC(4) && IN(4)) {
                pg8::StaticOrder S; S.init(F.XB(), (const bf16_t*)(F.wsp() + WS_WGU0), T, GU, D, F.G, opaque_s(bx));
                pg8::EpiGU E{(bf16_t*)(F.wsp() + WS_H), F.rss()};
                pg8::gemm_phase<pg8::EpiGU, pg8::StaticOrder, true, true>(glds, D, S, E);
                if (BOTH(4)) GRID_BAR();
            }
            asm volatile("; MARK DENSE_DN");
            if (PHC(5) && IN(5)) {
                pg8::StaticOrder S; S.init((const bf16_t*)(F.wsp() + WS_H), (const bf16_t*)(F.wsp() + WS_WDN0), T, D, FF, F.G, opaque_s(bx));
                pg8::EpiRes E{F.outp(), F.outp(), F.XB(), F.rss()};
                if (F.G == 256) pg8::gemm_phase<pg8::EpiRes, pg8::StaticOrder, false, true>(glds, FF, S, E);
                if (BOTH(5)) GRID_BAR();
            }
        }
    }
    asm volatile("; MARK ROUTER");
    if (PHC(6) && IN(9)) { refresh(F); router_phase(F); if (BOTH(9)) GRID_BAR(); }
    asm volatile("; MARK MOE_GU");
    if (PHC(7) && IN(10)) {
        pg8::MoeGatherOrder S; int nrb; moe_counts(F, S.pb, S.cn, nrb);
        S.nM = nrb; S.nN = GU / 256; S.G = F.G; S.c = opaque_s(bx); S.A = (const char*)F.XB(); S.Bt = (const char*)(F.wsp() + WS_MWGU); S.tstep = (size_t)256 * D * 2; S.estride = (size_t)GU * D * 2; S.tokof = F.tokof();
        pg8::EpiGUMoe E{(bf16_t*)(F.wsp() + WS_MH), F.rinvtok(), F.tokof()};
        pg8::gemm_phase<pg8::EpiGUMoe, pg8::MoeGatherOrder, true, true>(glds, D, S, E);
        if (BOTH(10)) GRID_BAR();
    }
    asm volatile("; MARK MOE_DN");
    if (PHC(8) && IN(11)) {
        pg8::MoePlainOrder S; int nrb; moe_counts(F, S.pb, S.cn, nrb);
        S.nM = nrb; S.nN = D / 256; S.G = F.G; S.c = opaque_s(bx); S.A = (const char*)(F.wsp() + WS_MH); S.Bt = (const char*)(F.wsp() + WS_MWDN); S.tstep = (size_t)256 * FF * 2; S.estride = (size_t)D * FF * 2; S.tokof = F.tokof();
        pg8::EpiDnMoe E{(bf16_t*)(F.wsp() + WS_YB), F.grow()};
        pg8::gemm_phase<pg8::EpiDnMoe, pg8::MoePlainOrder, true, true>(glds, FF, S, E);
        if (BOTH(11)) GRID_BAR();
    }
    asm volatile("; MARK FINAL");
    if (PHC(9) && IN(12)) { refresh(F); final_phase(F); }
#undef IN
#undef BOTH
#undef GRID_BAR
}

extern "C" void kernel_launch(void* const* d_in, const int* in_sizes, int n_in, void* d_out, int out_size, void* d_ws, size_t ws_size, hipStream_t stream) {
    static int grid = 0;
    if (grid == 0) {
        if (n_in != 17 || in_sizes[0] != T * D || out_size != T * D || ws_size < WS_END) { fprintf(stderr, "kernel_launch: unexpected shapes or workspace (n_in %d, out %d, ws %zu, need %zu); nothing launched\n", n_in, out_size, ws_size, (size_t)WS_END); grid = -1; return; }
        int dev = 0, cus = 0, per_cu = 0;
        if (hipGetDevice(&dev) != hipSuccess || hipDeviceGetAttribute(&cus, hipDeviceAttributeMultiprocessorCount, dev) != hipSuccess) { grid = -1; return; }
        if (hipFuncSetAttribute((const void*)trunk_fwd, hipFuncAttributeMaxDynamicSharedMemorySize, LDS_BYTES) != hipSuccess) { fprintf(stderr, "kernel_launch: hipFuncSetAttribute failed\n"); grid = -1; return; }
        if (hipOccupancyMaxActiveBlocksPerMultiprocessor(&per_cu, (const void*)trunk_fwd, NWAVES * 64, LDS_BYTES) != hipSuccess || per_cu < 1) { fprintf(stderr, "kernel_launch: occupancy query says %d blocks per CU\n", per_cu); (void)hipGetLastError(); grid = -1; return; }
        (void)hipGetLastError();
        grid = cus;
        if (grid != 256) fprintf(stderr, "kernel_launch: %d CUs; the residual GEMM phases need exactly 256 workgroups\n", grid);
    }
    if (grid < 0) return;
    if (hipMemsetAsync((char*)d_ws + WS_CTL, 0, CTL_ZERO_BYTES, stream) != hipSuccess) { fprintf(stderr, "kernel_launch: memset failed\n"); return; }
    Args a{};
    for (int i = 0; i < 17; ++i) a.in[i] = (const float*)d_in[i];
    a.out = (float*)d_out; a.ws = (unsigned char*)d_ws;
    if (MK_N_LAUNCHES == 1) {
        a.ph_lo = 0; a.ph_hi = NPHASE;
        void* kargs[] = {&a};
        const hipError_t le = hipLaunchCooperativeKernel((const void*)trunk_fwd, dim3(grid), dim3(NWAVES * 64), kargs, LDS_BYTES, stream);
        if (le != hipSuccess) fprintf(stderr, "kernel_launch: cooperative launch failed: %s (grid %d)\n", hipGetErrorName(le), grid);
    } else {
        for (int p = 0; p < NPHASE; ++p) { a.ph_lo = p; a.ph_hi = p + 1; hipLaunchKernelGGL(trunk_fwd, dim3(grid), dim3(NWAVES * 64), LDS_BYTES, stream, a); }
    }
}
```

```cpp
#include <hip/hip_runtime.h>
#include <cstdio>
#include <cstdint>

#define GAS __attribute__((address_space(1)))
#define LAS __attribute__((address_space(3)))
typedef unsigned short bf16_t;
typedef short bf16x8 __attribute__((ext_vector_type(8)));
typedef float f32x4 __attribute__((ext_vector_type(4)));
typedef float f32x2 __attribute__((ext_vector_type(2)));
typedef unsigned u32x4 __attribute__((ext_vector_type(4)));
typedef unsigned u32x2 __attribute__((ext_vector_type(2)));

#ifndef MK_N_LAUNCHES
#define MK_N_LAUNCHES 1
#endif
#ifndef PHMASK
#define PHMASK 0x3ff
#endif
#define PHC(c) (((PHMASK) >> (c)) & 1)

constexpr int NBATCH = 8, SEQ = 2048, T = NBATCH * SEQ, D = 1024, INC = 2816, FF = 2816, NEXP = 8, GU = 2 * FF;
constexpr int MAXRB = 135;
constexpr float RMS_EPS = 1e-6f, LN_EPS = 1e-5f;
constexpr float QSCALE = 0.125f * 1.4426950408889634f;
constexpr int NPHASE = 13;

constexpr size_t KiB = 1024, MiB = 1u << 20, HMiB = 1u << 19;
constexpr size_t WS_CTL = 0, CTL_ZERO_BYTES = 1 * MiB;
constexpr size_t WS_RSS = 1 * MiB;
constexpr size_t WS_RINV = WS_RSS + 256 * KiB;
constexpr size_t WS_KPART = WS_RINV + 64 * KiB;
constexpr size_t WS_TOKOF = 2 * MiB;
constexpr size_t WS_GROW = WS_TOKOF + 512 * KiB;
constexpr size_t WS_TSLOT = 3 * MiB;
constexpr size_t WS_WSGU = WS_TSLOT + 128 * KiB;
constexpr size_t WS_WIN = 4 * MiB;
constexpr size_t WS_WOUT = 15 * MiB;
constexpr size_t WS_WGU0 = 19 * MiB;
constexpr size_t WS_WDN0 = 30 * MiB;
constexpr size_t WS_MWDN = 71 * HMiB;
constexpr size_t WS_MWGU = 159 * HMiB;
constexpr size_t WS_XB = 335 * HMiB;
constexpr size_t WS_Z = 399 * HMiB;
constexpr size_t WS_Y = 575 * HMiB;
constexpr size_t WS_H = WS_Z;
constexpr size_t WS_MH = WS_Z;
constexpr size_t WS_YB = WS_MWGU;
constexpr size_t WS_END = WS_MH + (size_t)MAXRB * 256 * FF * 2;
static_assert(WS_WIN + 2 * (size_t)INC * D * 2 <= WS_WOUT && WS_WOUT + 2 * (size_t)D * D * 2 <= WS_WGU0 && WS_WGU0 + (size_t)GU * D * 2 <= WS_WDN0 && WS_WDN0 + (size_t)D * FF * 2 <= WS_MWDN, "ws map 1");
static_assert(WS_MWDN + 8 * (size_t)D * FF * 2 <= WS_MWGU && WS_MWGU + 8 * (size_t)GU * D * 2 <= WS_XB && WS_XB + (size_t)T * D * 2 <= WS_Z && WS_Z + (size_t)T * INC * 2 <= WS_Y, "ws map 2");
static_assert(WS_YB + (size_t)MAXRB * 256 * D * 2 <= WS_XB && WS_TSLOT + (size_t)T * 8 <= WS_WIN && WS_KPART + 64 * 2 * 256 * 4 <= WS_TOKOF, "ws map 3");
constexpr int CW_TMO = 0, CW_CODE = 1;
constexpr int CW_CNT = 64;
constexpr int CW_BAR = 4096;

constexpr int RING_BYTES = 131072;
constexpr int LDSCTL_OFF = RING_BYTES, MISC_OFF = LDSCTL_OFF + 320;
constexpr int LDS_BYTES = 147456;
constexpr int NWAVES = 8;

#define LDS_WAIT() asm volatile("s_waitcnt lgkmcnt(0)" ::: "memory")
#define VM_WAIT() asm volatile("s_waitcnt vmcnt(0)" ::: "memory")
#define RLX_AGENT __ATOMIC_RELAXED, __HIP_MEMORY_SCOPE_AGENT
typedef GAS unsigned gu32;

__device__ __forceinline__ unsigned cvt_pk_bf16(float lo, float hi) { unsigned r; asm volatile("v_cvt_pk_bf16_f32 %0, %1, %2" : "=v"(r) : "v"(lo), "v"(hi)); return r; }
__device__ __forceinline__ float bf_lo(unsigned w) { return __uint_as_float(w << 16); }
__device__ __forceinline__ float bf_hi(unsigned w) { return __uint_as_float(w & 0xffff0000u); }
__device__ __forceinline__ float fast_exp2(float x) { return __builtin_amdgcn_exp2f(x); }
__device__ __forceinline__ float fast_rcp(float x) { return __builtin_amdgcn_rcpf(x); }
__device__ __forceinline__ float silu_f(float g) { return g * fast_rcp(1.f + fast_exp2(-1.4426950408889634f * g)); }
__device__ __forceinline__ float gelu_tanh(float x) { const float u = 0.7978845608028654f * (x + 0.044715f * x * x * x); return x * fast_rcp(1.f + fast_exp2(-2.8853900817779268f * u)); }
__device__ __forceinline__ float wave_sum(float v) {
#pragma unroll
    for (int o = 1; o < 64; o <<= 1) v += __shfl_xor(v, o);
    return v;
}

namespace pg8 {
#define PG8_LAS __attribute__((address_space(3)))
constexpr int BM = 256, BK = 64, HALF = 128, HTB = HALF * BK * 2, STAGE_BYTES = 8 * HTB, NXCD = 8, WGM = 8;
__host__ __device__ __forceinline__ int lds_byte(int r, int c) { const int st = (r >> 4) * 2 + (c >> 5), rr = r & 15, cc = c & 31, ob = rr * 64 + cc * 2; return st * 1024 + (ob ^ (((ob >> 9) & 1) << 5)); }
__host__ __device__ __forceinline__ void stage_rc(int b, int& R, int& C) { const int st = b / 1024, sb = b % 1024, swz = sb ^ (((sb >> 9) & 1) << 5); R = (st >> 1) * 16 + swz / 64; C = (st & 1) * 32 + (swz % 64) / 2; }
__host__ __device__ __forceinline__ int perm32(int rho) { const int n = rho >> 4, i = rho & 15; return 8 * (i >> 2) + 4 * n + (i & 3); }

struct Unit { int pm, pn, e, rb, ce; };

__device__ __forceinline__ bool tile_order(int i, int G, int c, int nM, int nN, int& pm, int& pn) {
    const int nwg = nM * nN; const long L = (long)i * G + c; if (L >= nwg) return false;
    int wgid = (int)L; { const int q = nwg / NXCD, r = nwg % NXCD, xcd = wgid % NXCD, off = wgid / NXCD; wgid = (xcd < r ? xcd * (q + 1) : r * (q + 1) + (xcd - r) * q) + off; }
    const int nig = WGM * nN, gid = wgid / nig, fm = gid * WGM, gsz = (nM - fm) < WGM ? (nM - fm) : WGM;
    pm = fm + ((wgid % nig) % gsz); pn = (wgid % nig) / gsz; return true;
}
struct StaticOrder {
    static constexpr bool GATHER = false;
    int nM, nN, G, c; const char* A; const char* Bt; size_t tstep;
    __device__ __forceinline__ void init(const void* A_, const void* Bt_, int M, int N, int K, int G_, int c_) { nM = M / BM; nN = N / BM; G = G_; c = c_; A = (const char*)A_; Bt = (const char*)Bt_; tstep = (size_t)BM * K * 2; }
    __device__ __forceinline__ bool next(int i, Unit& u) const { u.e = 0; u.rb = 0; u.ce = 0; return tile_order(i, G, c, nM, nN, u.pm, u.pn); }
    __device__ __forceinline__ const char* a_ptr(const Unit& u) const { return A + (size_t)u.pm * tstep; }
    __device__ __forceinline__ const char* b_ptr(const Unit& u) const { return Bt + (size_t)u.pn * tstep; }
    __device__ __forceinline__ void a_voff(const Unit&, const int (&)[2], const int (&)[2], int, unsigned (&)[2][2]) const {}
};
struct MoeOrder {
    int nM, nN, G, c; const char* A; const char* Bt; size_t tstep, estride; const int* tokof;
    int pb[8], cn[8];
    __device__ __forceinline__ void locate(int pm, int& e, int& rb, int& ce) const {
        e = 0; rb = pm; ce = cn[0];
#pragma unroll
        for (int j = 1; j < 8; ++j) if (pm >= pb[j]) { e = j; rb = pm - pb[j]; ce = cn[j]; }
    }
    __device__ __forceinline__ bool next(int i, Unit& u) const { if (!tile_order(i, G, c, nM, nN, u.pm, u.pn)) return false; locate(u.pm, u.e, u.rb, u.ce); return true; }
    __device__ __forceinline__ const char* b_ptr(const Unit& u) const { return Bt + (size_t)u.e * estride + (size_t)u.pn * tstep; }
};
struct MoeGatherOrder : MoeOrder {
    static constexpr bool GATHER = true;
    __device__ __forceinline__ const char* a_ptr(const Unit&) const { return A; }
    __device__ __forceinline__ void a_voff(const Unit& u, const int (&R)[2], const int (&C)[2], int K, unsigned (&v)[2][2]) const {
#pragma unroll
        for (int h = 0; h < 2; ++h)
#pragma unroll
            for (int i = 0; i < 2; ++i) { const int r = u.rb * 256 + h * HALF + R[i]; int tok = 0; if (r < u.ce) tok = tokof[u.e * 16384 + r]; v[h][i] = (unsigned)(tok * K + C[i]) * 2u; }
    }
};
struct MoePlainOrder : MoeOrder {
    static constexpr bool GATHER = false;
    __device__ __forceinline__ const char* a_ptr(const Unit& u) const { return A + (size_t)u.pm * tstep; }
    __device__ __forceinline__ void a_voff(const Unit&, const int (&)[2], const int (&)[2], int, unsigned (&)[2][2]) const {}
};

__device__ __forceinline__ float row_rinv(const float* rss, int r) { const float ss = (rss[r] + rss[T + r]) + (rss[2 * T + r] + rss[3 * T + r]); return __builtin_amdgcn_rsqf(ss * (1.0f / D) + RMS_EPS); }

struct EpiIn {
    static constexpr bool PERM = true, AFTER_DRAIN = false;
    bf16_t* Z; const float* rss; float* kpart;
    __device__ __forceinline__ void operator()(const f32x4 (&acc)[2][2][4][2], const Unit& u, int wr, int wc, int fr, int fq) const {
        const int row0 = u.pm * BM + wr * 64 + fr; const int col0 = u.pn * BM + wc * 32 + 8 * fq;
        const float sc = (u.pn == 0 || u.pn == 8) ? QSCALE : 1.f;
        const bool ksum_tile = (u.pn == 1);
        f32x4 ks[2][2];
#pragma unroll
        for (int bj = 0; bj < 2; ++bj)
#pragma unroll
            for (int n = 0; n < 2; ++n) ks[bj][n] = (f32x4){0.f, 0.f, 0.f, 0.f};
        float riv[2][4];
#pragma unroll
        for (int ai = 0; ai < 2; ++ai)
#pragma unroll
            for (int m = 0; m < 4; ++m) riv[ai][m] = row_rinv(rss, row0 + ai * HALF + m * 16) * sc;
#pragma unroll
        for (int ai = 0; ai < 2; ++ai)
#pragma unroll
            for (int m = 0; m < 4; ++m) { const int r = row0 + ai * HALF + m * 16; const float ri = riv[ai][m]; bf16_t* rowp = Z + (size_t)r * INC + col0;
#pragma unroll
                for (int bj = 0; bj < 2; ++bj) { const f32x4 v0 = acc[ai][bj][m][0] * ri, v1 = acc[ai][bj][m][1] * ri;
                    if (ksum_tile) { ks[bj][0] += v0; ks[bj][1] += v1; }
                    u32x4 w; w.x = cvt_pk_bf16(v0[0], v0[1]); w.y = cvt_pk_bf16(v0[2], v0[3]); w.z = cvt_pk_bf16(v1[0], v1[1]); w.w = cvt_pk_bf16(v1[2], v1[3]);
                    *(u32x4*)(rowp + bj * HALF) = w; } }
        if (ksum_tile) {
#pragma unroll
            for (int bj = 0; bj < 2; ++bj)
#pragma unroll
                for (int n = 0; n < 2; ++n)
#pragma unroll
                    for (int e = 0; e < 4; ++e) { float s = ks[bj][n][e]; s += __shfl_xor(s, 1); s += __shfl_xor(s, 2); s += __shfl_xor(s, 4); s += __shfl_xor(s, 8); ks[bj][n][e] = s; }
            if (fr == 0) { float* kp = kpart + ((size_t)u.pm * 2 + wr) * 256 + wc * 32 + 8 * fq;
#pragma unroll
                for (int bj = 0; bj < 2; ++bj) { *(f32x4*)(kp + bj * HALF) = ks[bj][0]; *(f32x4*)(kp + bj * HALF + 4) = ks[bj][1]; } }
        }
    }
};
struct EpiGU {
    static constexpr bool PERM = true, AFTER_DRAIN = false;
    bf16_t* H; const float* rss;
    __device__ __forceinline__ void operator()(const f32x4 (&acc)[2][2][4][2], const Unit& u, int wr, int wc, int fr, int fq) const {
        const int row0 = u.pm * BM + wr * 64 + fr; const int col0 = u.pn * HALF + wc * 32 + 8 * fq;
        float riv[2][4];
#pragma unroll
        for (int ai = 0; ai < 2; ++ai)
#pragma unroll
            for (int m = 0; m < 4; ++m) riv[ai][m] = row_rinv(rss, row0 + ai * HALF + m * 16);
#pragma unroll
        for (int ai = 0; ai < 2; ++ai)
#pragma unroll
            for (int m = 0; m < 4; ++m) { const int r = row0 + ai * HALF + m * 16; const float ri = riv[ai][m];
                float hv[8];
#pragma unroll
                for (int n = 0; n < 2; ++n)
#pragma unroll
                    for (int e = 0; e < 4; ++e) hv[4 * n + e] = silu_f(acc[ai][0][m][n][e] * ri) * (acc[ai][1][m][n][e] * ri);
                u32x4 w; w.x = cvt_pk_bf16(hv[0], hv[1]); w.y = cvt_pk_bf16(hv[2], hv[3]); w.z = cvt_pk_bf16(hv[4], hv[5]); w.w = cvt_pk_bf16(hv[6], hv[7]);
                *(u32x4*)(H + (size_t)r * FF + col0) = w; }
    }
};
struct EpiGUMoe {
    static constexpr bool PERM = true, AFTER_DRAIN = false;
    bf16_t* H; const float* rinvtok; const int* tokof;
    __device__ __forceinline__ void operator()(const f32x4 (&acc)[2][2][4][2], const Unit& u, int wr, int wc, int fr, int fq) const {
        const int rl0 = wr * 64 + fr; const int col0 = u.pn * HALF + wc * 32 + 8 * fq;
        int tkv[2][4]; float riv[2][4];
#pragma unroll
        for (int ai = 0; ai < 2; ++ai)
#pragma unroll
            for (int m = 0; m < 4; ++m) { const int re = u.rb * 256 + rl0 + ai * HALF + m * 16; int tok = 0; if (re < u.ce) tok = tokof[u.e * 16384 + re]; tkv[ai][m] = tok; }
#pragma unroll
        for (int ai = 0; ai < 2; ++ai)
#pragma unroll
            for (int m = 0; m < 4; ++m) riv[ai][m] = rinvtok[tkv[ai][m]];
#pragma unroll
        for (int ai = 0; ai < 2; ++ai)
#pragma unroll
            for (int m = 0; m < 4; ++m) { const int rl = rl0 + ai * HALF + m * 16; const float ri = riv[ai][m];
                float hv[8];
#pragma unroll
                for (int n = 0; n < 2; ++n)
#pragma unroll
                    for (int e = 0; e < 4; ++e) hv[4 * n + e] = silu_f(acc[ai][0][m][n][e] * ri) * (acc[ai][1][m][n][e] * ri);
                u32x4 w; w.x = cvt_pk_bf16(hv[0], hv[1]); w.y = cvt_pk_bf16(hv[2], hv[3]); w.z = cvt_pk_bf16(hv[4], hv[5]); w.w = cvt_pk_bf16(hv[6], hv[7]);
                *(u32x4*)(H + (size_t)(u.pm * BM + rl) * FF + col0) = w; }
    }
};
struct EpiDnMoe {
    static constexpr bool PERM = true, AFTER_DRAIN = false;
    bf16_t* YB; const float* grow;
    __device__ __forceinline__ void operator()(const f32x4 (&acc)[2][2][4][2], const Unit& u, int wr, int wc, int fr, int fq) const {
        const int rl0 = wr * 64 + fr; const int col0 = u.pn * BM + wc * 32 + 8 * fq;
        float gwv[2][4];
#pragma unroll
        for (int ai = 0; ai < 2; ++ai)
#pragma unroll
            for (int m = 0; m < 4; ++m) { const int re = u.rb * 256 + rl0 + ai * HALF + m * 16; float gw = 0.f; if (re < u.ce) gw = grow[u.e * 16384 + re]; gwv[ai][m] = gw; }
#pragma unroll
        for (int ai = 0; ai < 2; ++ai)
#pragma unroll
            for (int m = 0; m < 4; ++m) { const int rl = rl0 + ai * HALF + m * 16; const float gw = gwv[ai][m];
                bf16_t* rowp = YB + (size_t)(u.pm * BM + rl) * D + col0;
#pragma unroll
                for (int bj = 0; bj < 2; ++bj) { const f32x4 v0 = acc[ai][bj][m][0] * gw, v1 = acc[ai][bj][m][1] * gw;
                    u32x4 w; w.x = cvt_pk_bf16(v0[0], v0[1]); w.y = cvt_pk_bf16(v0[2], v0[3]); w.z = cvt_pk_bf16(v1[0], v1[1]); w.w = cvt_pk_bf16(v1[2], v1[3]);
                    *(u32x4*)(rowp + bj * HALF) = w; } }
    }
};
struct EpiRes {
    static constexpr bool PERM = true, AFTER_DRAIN = true;
    const float* base; float* out; bf16_t* xb; float* rss;
    __device__ __forceinline__ void fused(f32x4 (&acc)[2][2][4][2], const Unit& u, int wr, int wc, int fr, int fq, PG8_LAS unsigned char* lds, int wid, int lane) const {
        PG8_LAS float* P = (PG8_LAS float*)lds;
        const int col0 = u.pn * BM + wc * 32 + 8 * fq;
#pragma unroll
        for (int ai = 0; ai < 2; ++ai)
#pragma unroll
            for (int m = 0; m < 4; ++m) { const int rl = ai * HALF + wr * 64 + m * 16 + fr; const size_t off = (size_t)(u.pm * BM + rl) * D + col0; float ss = 0.f;
#pragma unroll
                for (int bj = 0; bj < 2; ++bj) { const f32x4 b0 = *(const f32x4*)(base + off + bj * HALF), b1 = *(const f32x4*)(base + off + bj * HALF + 4);
                    const f32x4 x0 = b0 + acc[ai][bj][m][0], x1 = b1 + acc[ai][bj][m][1];
                    *(f32x4*)(out + off + bj * HALF) = x0; *(f32x4*)(out + off + bj * HALF + 4) = x1;
                    u32x4 w; w.x = cvt_pk_bf16(x0[0], x0[1]); w.y = cvt_pk_bf16(x0[2], x0[3]); w.z = cvt_pk_bf16(x1[0], x1[1]); w.w = cvt_pk_bf16(x1[2], x1[3]);
                    *(u32x4*)(xb + off + bj * HALF) = w;
                    ss += (x0[0] * x0[0] + x0[1] * x0[1]) + (x0[2] * x0[2] + x0[3] * x0[3]) + (x1[0] * x1[0] + x1[1] * x1[1]) + (x1[2] * x1[2] + x1[3] * x1[3]); }
                ss += __shfl_xor(ss, 16); ss += __shfl_xor(ss, 32);
                if (fq == 0) P[rl * 4 + wc] = ss;
                asm volatile("" ::: "memory"); }
        asm volatile("s_waitcnt lgkmcnt(0)" ::: "memory"); __builtin_amdgcn_s_barrier(); asm volatile("" ::: "memory");
        const int t = wid * 64 + lane;
        if (t < 256) { const f32x4 p = *(const PG8_LAS f32x4*)(P + t * 4); rss[(size_t)u.pn * T + u.pm * BM + t] = (p[0] + p[1]) + (p[2] + p[3]); }
    }
};

template <class Epi, class Sched, bool ALIGN_EPI, bool SP2>
__device__ __forceinline__ void gemm_phase(PG8_LAS unsigned char* lds, const int K, const Sched& S, const Epi& E) {
    int tid_ = threadIdx.x; asm volatile("" : "+v"(tid_));
    const int tid = tid_, wid = __builtin_amdgcn_readfirstlane(tid >> 6), lane = tid & 63, wr = wid >> 2, wc = wid & 3, fr = lane & 15, fq = lane >> 4;
    const int nt = K / BK;
    unsigned voffA[2], voffB[2]; int stR[2], stC[2];
#pragma unroll
    for (int i = 0; i < 2; ++i) { int R, C; stage_rc(tid * 16 + i * 8192, R, C); const int Rb = Epi::PERM ? ((R & ~31) + perm32(R & 31)) : R;
        voffA[i] = (unsigned)(R * K + C) * 2u; voffB[i] = (unsigned)(Rb * K + C) * 2u; stR[i] = R; stC[i] = C; }
    const size_t kstep = (size_t)(BK * 2);
    const size_t hstep = (size_t)HALF * K * 2;
    const unsigned ldsw = (unsigned)wid * 1024u;
    const int aoff = lds_byte(wr * 64 + fr, fq * 8), boff = lds_byte(wc * 32 + fr, fq * 8);
#define PG8_SA(b, h) (((b) * 2 + (h)) * HTB)
#define PG8_SB(b, h) ((4 + (b) * 2 + (h)) * HTB)
#define PG8_STAGE(bufoff, gbase, voff) do { _Pragma("unroll") for (int _i = 0; _i < 2; ++_i) \
        __builtin_amdgcn_global_load_lds((const unsigned*)((const char*)(gbase) + (voff)[_i]), (PG8_LAS unsigned*)(lds + (bufoff) + ldsw + _i * 8192), 16, 0, 0); } while (0)
#define PG8_STG_A(bufoff, h, kptr, VG) do { if constexpr (Sched::GATHER) { PG8_STAGE(bufoff, kptr, VG[h]); } else { PG8_STAGE(bufoff, (kptr) + (h) * hstep, voffA); } } while (0)
#define PG8_LDA(dst, b, h) do { _Pragma("unroll") for (int m = 0; m < 4; ++m) _Pragma("unroll") for (int k = 0; k < 2; ++k) dst[m][k] = *(const PG8_LAS bf16x8*)(lds + PG8_SA(b, h) + aoff + m * 2048 + k * 1024); } while (0)
#define PG8_LDB(dst, b, h) do { _Pragma("unroll") for (int n = 0; n < 2; ++n) _Pragma("unroll") for (int k = 0; k < 2; ++k) dst[n][k] = *(const PG8_LAS bf16x8*)(lds + PG8_SB(b, h) + boff + n * 2048 + k * 1024); } while (0)
#define PG8_MMA(ai, bj, At, Bt) do { __builtin_amdgcn_s_setprio(1); _Pragma("unroll") for (int m = 0; m < 4; ++m) _Pragma("unroll") for (int n = 0; n < 2; ++n) _Pragma("unroll") for (int k = 0; k < 2; ++k) \
        acc[ai][bj][m][n] = __builtin_amdgcn_mfma_f32_16x16x32_bf16(Bt[n][k], At[m][k], acc[ai][bj][m][n], 0, 0, 0); __builtin_amdgcn_s_setprio(0); } while (0)
#define PG8_WAIT_V(n) asm volatile("s_waitcnt vmcnt(" #n ")" ::: "memory")
#define PG8_WAIT_L(n) asm volatile("s_waitcnt lgkmcnt(" #n ")" ::: "memory")
#define PG8_BAR __builtin_amdgcn_s_barrier()
#define PG8_SCHED __builtin_amdgcn_sched_barrier(0)
    Unit cur, nxt; int ui = 0;
    if (!S.next(0, cur)) return;
    f32x4 acc[2][2][4][2];
#pragma unroll
    for (int a = 0; a < 2; ++a)
#pragma unroll
        for (int b = 0; b < 2; ++b)
#pragma unroll
            for (int m = 0; m < 4; ++m)
#pragma unroll
                for (int n = 0; n < 2; ++n) acc[a][b][m][n] = (f32x4){0.f, 0.f, 0.f, 0.f};
    bf16x8 At[4][2], B0[2][2], B1[2][2];
    unsigned vgc[2][2] = {{0u, 0u}, {0u, 0u}}, vgn[2][2] = {{0u, 0u}, {0u, 0u}};
    const char* cA = S.a_ptr(cur); const char* cB = S.b_ptr(cur);
    if constexpr (Sched::GATHER) { S.a_voff(cur, stR, stC, K, vgc); asm volatile("" : "+v"(vgc[0][0]), "+v"(vgc[0][1]), "+v"(vgc[1][0]), "+v"(vgc[1][1])); }
    if constexpr (SP2) {
        PG8_STAGE(PG8_SB(0, 0), cB, voffB); PG8_STAGE(PG8_SB(0, 1), cB + hstep, voffB); PG8_STG_A(PG8_SA(0, 0), 0, cA, vgc); PG8_STG_A(PG8_SA(0, 1), 1, cA, vgc);
        if (wr == 1) PG8_BAR;
        PG8_WAIT_V(2); PG8_BAR;
        PG8_STAGE(PG8_SB(1, 0), cB + kstep, voffB); PG8_STG_A(PG8_SA(1, 0), 0, cA + kstep, vgc); PG8_STAGE(PG8_SB(1, 1), cB + hstep + kstep, voffB);
        PG8_WAIT_V(6); PG8_BAR;
    } else {
        PG8_STAGE(PG8_SB(0, 0), cB, voffB); PG8_STG_A(PG8_SA(0, 0), 0, cA, vgc); PG8_STAGE(PG8_SB(0, 1), cB + hstep, voffB); PG8_STG_A(PG8_SA(0, 1), 1, cA, vgc);
        if (wr == 1) PG8_BAR;
        PG8_WAIT_V(4); PG8_BAR;
        PG8_STAGE(PG8_SB(1, 0), cB + kstep, voffB); PG8_STG_A(PG8_SA(1, 0), 0, cA + kstep, vgc); PG8_STAGE(PG8_SB(1, 1), cB + hstep + kstep, voffB);
        PG8_WAIT_V(6); PG8_BAR;
    }
    for (;;) {
        const bool has_next = S.next(ui + 1, nxt);
        const char* nA = has_next ? S.a_ptr(nxt) : cA; const char* nB = has_next ? S.b_ptr(nxt) : cB;
        if constexpr (Sched::GATHER) {
            if (has_next) S.a_voff(nxt, stR, stC, K, vgn); else { vgn[0][0] = vgc[0][0]; vgn[0][1] = vgc[0][1]; vgn[1][0] = vgc[1][0]; vgn[1][1] = vgc[1][1]; }
            asm volatile("" : "+v"(vgn[0][0]), "+v"(vgn[0][1]), "+v"(vgn[1][0]), "+v"(vgn[1][1]));
        }
        for (int t = 0; t < nt; t += 2) {
            const bool last = (t == nt - 2);
            const char* a1 = cA + (size_t)(t + 1) * kstep;
            const char* a2 = last ? nA : cA + (size_t)(t + 2) * kstep; const char* b2 = last ? nB : cB + (size_t)(t + 2) * kstep;
            const char* a3 = a2 + kstep; const char* b3 = b2 + kstep;
            unsigned vgx[2][2];
            if constexpr (Sched::GATHER) {
#pragma unroll
                for (int h = 0; h < 2; ++h)
#pragma unroll
                    for (int i = 0; i < 2; ++i) vgx[h][i] = last ? vgn[h][i] : vgc[h][i];
            }
            if constexpr (SP2) {
            PG8_LDB(B0, 0, 0); PG8_LDB(B1, 0, 1); PG8_SCHED; PG8_LDA(At, 0, 0); PG8_STG_A(PG8_SA(1, 1), 1, a1, vgc);
            PG8_WAIT_V(8); PG8_WAIT_L(0); PG8_BAR; PG8_MMA(0, 0, At, B0); PG8_MMA(0, 1, At, B1); PG8_BAR; PG8_SCHED;
            PG8_LDA(At, 0, 1); PG8_STAGE(PG8_SB(0, 0), b2, voffB); PG8_STAGE(PG8_SB(0, 1), b2 + hstep, voffB); PG8_STG_A(PG8_SA(0, 0), 0, a2, vgx);
            PG8_WAIT_V(8); PG8_WAIT_L(0); PG8_BAR; PG8_MMA(1, 0, At, B0); PG8_MMA(1, 1, At, B1); PG8_BAR; PG8_SCHED;
            PG8_LDB(B0, 1, 0); PG8_LDB(B1, 1, 1); PG8_SCHED; PG8_LDA(At, 1, 0); PG8_STG_A(PG8_SA(0, 1), 1, a2, vgx);
            PG8_WAIT_V(8); PG8_WAIT_L(0); PG8_BAR; PG8_MMA(0, 0, At, B0); PG8_MMA(0, 1, At, B1); PG8_BAR; PG8_SCHED;
            PG8_LDA(At, 1, 1); PG8_STAGE(PG8_SB(1, 0), b3, voffB); PG8_STAGE(PG8_SB(1, 1), b3 + hstep, voffB); PG8_STG_A(PG8_SA(1, 0), 0, a3, vgx);
            PG8_WAIT_V(8); PG8_WAIT_L(0); PG8_BAR; PG8_MMA(1, 0, At, B0); PG8_MMA(1, 1, At, B1); PG8_BAR; PG8_SCHED;
            } else {
            PG8_LDB(B0, 0, 0); PG8_SCHED; PG8_LDA(At, 0, 0); PG8_STG_A(PG8_SA(1, 1), 1, a1, vgc);
            PG8_WAIT_L(8); PG8_BAR; PG8_WAIT_L(0); PG8_MMA(0, 0, At, B0); PG8_BAR; PG8_SCHED;
            PG8_LDB(B1, 0, 1); PG8_STAGE(PG8_SB(0, 0), b2, voffB);
            PG8_BAR; PG8_WAIT_L(0); PG8_MMA(0, 1, At, B1); PG8_BAR;
            PG8_LDA(At, 0, 1); PG8_STG_A(PG8_SA(0, 0), 0, a2, vgx);
            PG8_BAR; PG8_WAIT_L(0); PG8_MMA(1, 0, At, B0); PG8_BAR; PG8_SCHED;
            PG8_STAGE(PG8_SB(0, 1), b2 + hstep, voffB);
            PG8_WAIT_V(6); PG8_BAR; PG8_MMA(1, 1, At, B1); PG8_BAR;
            PG8_LDB(B0, 1, 0); PG8_SCHED; PG8_LDA(At, 1, 0); PG8_STG_A(PG8_SA(0, 1), 1, a2, vgx);
            PG8_WAIT_L(8); PG8_BAR; PG8_WAIT_L(0); PG8_MMA(0, 0, At, B0); PG8_BAR; PG8_SCHED;
            PG8_LDB(B1, 1, 1); PG8_STAGE(PG8_SB(1, 0), b3, voffB);
            PG8_BAR; PG8_WAIT_L(0); PG8_MMA(0, 1, At, B1); PG8_BAR;
            PG8_LDA(At, 1, 1); PG8_STG_A(PG8_SA(1, 0), 0, a3, vgx);
            PG8_BAR; PG8_WAIT_L(0); PG8_MMA(1, 0, At, B0); PG8_BAR; PG8_SCHED;
            PG8_STAGE(PG8_SB(1, 1), b3 + hstep, voffB);
            PG8_WAIT_V(6); PG8_BAR; PG8_MMA(1, 1, At, B1); PG8_BAR;
            }
        }
        if constexpr (ALIGN_EPI) { if (wr == 0) PG8_BAR; }
        if constexpr (!Epi::AFTER_DRAIN) { E(acc, cur, wr, wc, fr, fq); }
        if (!has_next) break;
#pragma unroll
        for (int a = 0; a < 2; ++a)
#pragma unroll
            for (int b = 0; b < 2; ++b)
#pragma unroll
                for (int m = 0; m < 4; ++m)
#pragma unroll
                    for (int n = 0; n < 2; ++n) acc[a][b][m][n] = (f32x4){0.f, 0.f, 0.f, 0.f};
        cur = nxt; cA = nA; cB = nB; ++ui;
        if constexpr (Sched::GATHER) { vgc[0][0] = vgn[0][0]; vgc[0][1] = vgn[0][1]; vgc[1][0] = vgn[1][0]; vgc[1][1] = vgn[1][1]; }
        if constexpr (ALIGN_EPI) { if (wr == 1) PG8_BAR; }
    }
    PG8_WAIT_V(0);
    if constexpr (!ALIGN_EPI) { if (wr == 0) PG8_BAR; }
    PG8_BAR;
    if constexpr (Epi::AFTER_DRAIN) { E.fused(acc, cur, wr, wc, fr, fq, lds, wid, lane); }
#undef PG8_SA
#undef PG8_SB
#undef PG8_STAGE
#undef PG8_STG_A
#undef PG8_LDA
#undef PG8_LDB
#undef PG8_MMA
#undef PG8_WAIT_V
#undef PG8_WAIT_L
#undef PG8_BAR
#undef PG8_SCHED
}
}

#define XB_TMO      128
#define XB_XCNT(j)  (256  + 64 * (j))
#define XB_XSUB(j)  (1280 + 64 * (j))
#define XB_XGEN(j)  (2304 + 64 * (j))
#define XB_TOP      3328
#define XB_TOPGEN   3392
#define XCD_BAR_WORDS 3456
#define XB_SPIN_CAP (1u << 18)
__device__ __forceinline__ unsigned xb_ld(unsigned* p)              { return __hip_atomic_load(p, __ATOMIC_RELAXED, __HIP_MEMORY_SCOPE_AGENT); }
__device__ __forceinline__ unsigned xb_add(unsigned* p, unsigned v) { return __hip_atomic_fetch_add(p, v, __ATOMIC_RELAXED, __HIP_MEMORY_SCOPE_AGENT); }
__device__ __forceinline__ unsigned xb_xcc_id() { return (unsigned)__builtin_amdgcn_s_getreg((3 << 11) | 20) & 0xFu; }
#define XB_SPIN(cond, bar) do { unsigned _sp = 0; while (cond) { __builtin_amdgcn_s_sleep(1); \
    if ((++_sp & 255u) == 0u) { if (xb_ld(&(bar)[XB_TMO])) break; if (_sp > XB_SPIN_CAP) { atomicAdd(&(bar)[XB_TMO], 1u); break; } } } } while (0)
struct XcdBarrier { unsigned* bar; unsigned x; volatile LAS unsigned* st; };
__device__ __forceinline__ XcdBarrier xcd_barrier_post(unsigned* bar, volatile LAS unsigned* st) {
    XcdBarrier b; b.bar = bar; b.x = xb_xcc_id(); b.st = st;
    if (threadIdx.x == 0) (void)xb_add(&bar[XB_XCNT(b.x)], 1u);
    return b;
}
__device__ __forceinline__ void xcd_barrier_complete(unsigned* bar, unsigned x, unsigned& nloc, unsigned& nx) {
    const unsigned G = gridDim.x * gridDim.y * gridDim.z;
    unsigned sum, cnt, mine, sp = 0u;
    for (;;) {
        sum = 0u; cnt = 0u; mine = 0u;
#pragma unroll
        for (unsigned j = 0; j < 16; ++j) { const unsigned c = xb_ld(&bar[XB_XCNT(j)]); sum += c; cnt += (c > 0u) ? 1u : 0u; mine = (j == x) ? c : mine; }
        if (sum == G) break;
        __builtin_amdgcn_s_sleep(1);
        if ((++sp & 255u) == 0u) { if (xb_ld(&bar[XB_TMO])) break; if (sp > XB_SPIN_CAP) { atomicAdd(&bar[XB_TMO], 1u); break; } }
    }
    nloc = mine > 0u ? mine : 1u; nx = cnt > 0u ? cnt : 1u;
}
__device__ __forceinline__ void xcd_barrier(const XcdBarrier& b) {
    asm volatile("s_waitcnt vmcnt(0)" ::: "memory");
    __syncthreads();
    if (threadIdx.x == 0) {
        unsigned* bar = b.bar;
        __builtin_amdgcn_s_waitcnt(0);
        unsigned nloc = b.st[0], nx = b.st[1];
        if (nloc == 0u) { xcd_barrier_complete(bar, b.x, nloc, nx); b.st[0] = nloc; b.st[1] = nx; }
        const unsigned old = xb_add(&bar[XB_XSUB(b.x)], 1u);
        const unsigned gen = old / nloc;
        if (old + 1u == (gen + 1u) * nloc) {
            __builtin_amdgcn_fence(__ATOMIC_RELEASE, "agent");
            asm volatile("s_waitcnt vmcnt(0)" ::: "memory");
            const unsigned og = xb_add(&bar[XB_TOP], 1u);
            const unsigned tg = og / nx;
            if (og + 1u == (tg + 1u) * nx) xb_add(&bar[XB_TOPGEN], 1u);
            else XB_SPIN(xb_ld(&bar[XB_TOPGEN]) == tg, bar);
            __builtin_amdgcn_fence(__ATOMIC_ACQUIRE, "agent");
            xb_add(&bar[XB_XGEN(b.x)], 1u);
            asm volatile("s_waitcnt vmcnt(0)" ::: "memory");
        } else {
            XB_SPIN(xb_ld(&bar[XB_XGEN(b.x)]) == gen, bar);
            __builtin_amdgcn_fence(__ATOMIC_ACQUIRE, "agent");
            asm volatile("s_waitcnt vmcnt(0)" ::: "memory");
        }
    }
    __syncthreads();
}

namespace attn_body {
using bf16=unsigned short;
using bf16x8=__attribute__((ext_vector_type(8)))short;
using s16x4=__attribute__((ext_vector_type(4)))short;
using f32x16=__attribute__((ext_vector_type(16)))float;
using u32x4=__attribute__((ext_vector_type(4)))unsigned;
using f32x4v=__attribute__((ext_vector_type(4)))float;
constexpr int SEQ=2048,D=64,PITCH=2816,OPITCH=1024;
constexpr int NW=8,QBLK=32,QB=QBLK*NW,KVBLK=64;
__device__ __forceinline__ int crow(int r,int hi){return (r&3)+8*(r>>2)+4*hi;}
#define SBAR() __builtin_amdgcn_sched_barrier(0)
__device__ __forceinline__ void cmask(f32x16&p0,f32x16&p1,int jb,int qrel,int hi){
  const float NEG=-INFINITY; int kb=64*jb+4*hi;
  #pragma unroll
  for(int r=0;r<16;++r){int kv=kb+(r&3)+8*(r>>2); if(kv>qrel)p0[r]=NEG; if(kv+32>qrel)p1[r]=NEG;}
}
constexpr int NSLOT=3, SLOTB=8192;
constexpr int LDS_K=0, LDS_V=NSLOT*SLOTB, LDS_WS=2*NSLOT*SLOTB, LDS_OST=LDS_WS+NW*64*4, LDS_KSUM=LDS_OST+NW*4096, LDS_LUT=LDS_KSUM+2048, LUT_N=2304, LDS_BYTES=LDS_LUT+LUT_N*16;
__device__ __forceinline__ void glds16(const void*gsrc,unsigned lds_dst){unsigned keep;
  asm volatile("s_mov_b32 %0, m0\n\ts_mov_b32 m0, %2\n\ts_nop 0\n\tglobal_load_lds_dwordx4 %1, off\n\ts_mov_b32 m0, %0":"=&s"(keep):"v"(gsrc),"s"(lds_dst):"memory");}
__device__ __forceinline__ float max3f(float a,float b,float c){float r;asm("v_max3_f32 %0, %1, %2, %3":"=v"(r):"v"(a),"v"(b),"v"(c));return r;}
__device__ __forceinline__ float max2f(float a,float b){float r;asm("v_max_f32_e32 %0, %1, %2":"=v"(r):"v"(a),"v"(b));return r;}
__device__ __forceinline__ float fadd_s(float a,float b){float r;asm("v_add_f32_e32 %0, %1, %2":"=v"(r):"v"(a),"v"(b));return r;}
__device__ __forceinline__ float fsub_s(float a,float b){float r;asm("v_sub_f32_e32 %0, %1, %2":"=v"(r):"v"(a),"v"(b));return r;}
typedef float f32x2_t __attribute__((ext_vector_type(2))); typedef __bf16 bf16x2_t __attribute__((ext_vector_type(2)));
__device__ __forceinline__ unsigned cvtpk_s(float lo,float hi){f32x2_t v={lo,hi};bf16x2_t b=__builtin_convertvector(v,bf16x2_t);return __builtin_bit_cast(unsigned,b);}
#define WAIT_BAR(N) asm volatile("s_waitcnt vmcnt(" #N ") lgkmcnt(0)\n\ts_barrier":::"memory")

__device__ __forceinline__ void qkt(f32x16&p0,f32x16&p1,const char*Kslot,const bf16x8*qr,int r32,int hi){
  const char*kb=Kslot+hi*1024+r32*16;
  #pragma unroll
  for(int d0=0;d0<4;++d0){
    const bf16x8 b0=*reinterpret_cast<const bf16x8*>(kb+d0*2048);
    const bf16x8 b1=*reinterpret_cast<const bf16x8*>(kb+d0*2048+512);
    p0=__builtin_amdgcn_mfma_f32_32x32x16_bf16(b0,qr[d0],p0,0,0,0);p1=__builtin_amdgcn_mfma_f32_32x32x16_bf16(b1,qr[d0],p1,0,0,0);}
}
typedef __attribute__((address_space(3))) const char* lds_cptr;
typedef short v4i16_t __attribute__((ext_vector_type(4)));
__device__ __forceinline__ void kload8(bf16x8*kf,lds_cptr kp){
  kf[0]=*(const __attribute__((address_space(3))) bf16x8*)(kp);      kf[1]=*(const __attribute__((address_space(3))) bf16x8*)(kp+512);
  kf[2]=*(const __attribute__((address_space(3))) bf16x8*)(kp+2048); kf[3]=*(const __attribute__((address_space(3))) bf16x8*)(kp+2560);
  kf[4]=*(const __attribute__((address_space(3))) bf16x8*)(kp+4096); kf[5]=*(const __attribute__((address_space(3))) bf16x8*)(kp+4608);
  kf[6]=*(const __attribute__((address_space(3))) bf16x8*)(kp+6144); kf[7]=*(const __attribute__((address_space(3))) bf16x8*)(kp+6656);
}
__device__ __forceinline__ void kload2(bf16x8*kf,lds_cptr kp,int j){ kf[2*j]=*(const __attribute__((address_space(3))) bf16x8*)(kp+j*2048); kf[2*j+1]=*(const __attribute__((address_space(3))) bf16x8*)(kp+j*2048+512); }
__device__ __forceinline__ s16x4 vtr(lds_cptr p){ return __builtin_bit_cast(s16x4,__builtin_amdgcn_ds_read_tr16_b64_v4i16((__attribute__((address_space(3))) v4i16_t*)p)); }
__device__ __forceinline__ float rowmax(const f32x16&p0,const f32x16&p1){
  float a=max3f(p0[0],p0[1],p1[0]),b=max3f(p0[2],p0[3],p1[1]);a=max3f(a,p1[2],p1[3]);
  #pragma unroll
  for(int r=4;r<16;r+=4){a=max3f(a,p0[r],p0[r+1]);b=max3f(b,p0[r+2],p0[r+3]);a=max3f(a,p1[r],p1[r+1]);b=max3f(b,p1[r+2],p1[r+3]);}
  const float m=max2f(a,b);
  auto rr=__builtin_amdgcn_permlane32_swap(__float_as_uint(m),__float_as_uint(m),false,false);
  return max2f(__uint_as_float(rr[0]),__uint_as_float(rr[1]));
}
__device__ __forceinline__ void pv(f32x16*o,int vb,bf16x8 pa0,bf16x8 pa1,bf16x8 pa2,bf16x8 pa3){
  #pragma unroll
  for(int d0=0;d0<2;++d0){s16x4 lo[4],hi[4];
    #pragma unroll
    for(int ks=0;ks<4;++ks){
      asm volatile("ds_read_b64_tr_b16 %0,%1 offset:%c2":"=&v"(lo[ks]):"v"(vb),"i"(d0*4096+ks*1024):"memory");
      asm volatile("ds_read_b64_tr_b16 %0,%1 offset:%c2":"=&v"(hi[ks]):"v"(vb),"i"(d0*4096+ks*1024+512):"memory");}
    asm volatile("s_waitcnt lgkmcnt(0)":::"memory");SBAR();
    #define PK(k) (bf16x8){lo[k][0],lo[k][1],lo[k][2],lo[k][3],hi[k][0],hi[k][1],hi[k][2],hi[k][3]}
    o[d0]=__builtin_amdgcn_mfma_f32_32x32x16_bf16(pa0,PK(0),o[d0],0,0,0);
    o[d0]=__builtin_amdgcn_mfma_f32_32x32x16_bf16(pa1,PK(1),o[d0],0,0,0);
    o[d0]=__builtin_amdgcn_mfma_f32_32x32x16_bf16(pa2,PK(2),o[d0],0,0,0);
    o[d0]=__builtin_amdgcn_mfma_f32_32x32x16_bf16(pa3,PK(3),o[d0],0,0,0);
    #undef PK
  }
}
__device__ __forceinline__ float dil_bias(int d){
  if(d<0)return -INFINITY;
  const int c=(d<=128?1:0)+(((d&3)==0&&d<=512)?1:0)+(((d&15)==0)?1:0);
  return c==0?-INFINITY:(c==1?0.f:(c==2?1.f:1.5849625007211562f));
}
__device__ __forceinline__ void build_dil_lut(char*shm){
  float*lut=(float*)(shm+LDS_LUT);
  for(int x=threadIdx.x;x<LUT_N;x+=512){ const int d=x-256; *(f32x4v*)(lut+4*x)=(f32x4v){dil_bias(d),dil_bias(d-1),dil_bias(d-2),dil_bias(d-3)}; }
  asm volatile("s_waitcnt lgkmcnt(0)\n\ts_barrier":::"memory");
}
__device__ __forceinline__ void stage_ksum(char*shm,const float*kpart,int b,int h){
  float*ksm=(float*)(shm+LDS_KSUM); const int tid=threadIdx.x,j=tid>>6,d=tid&63;
  const float*kp=kpart+((size_t)(b*8+j)*2)*256+h*64+d; ksm[tid]=kp[0]+kp[256];
  asm volatile("s_waitcnt vmcnt(0) lgkmcnt(0)\n\ts_barrier":::"memory");
}

template<int MODE,int THRL> __device__ __forceinline__ void attn_unit(int b,int h,int qb,const bf16*Q,const bf16*__restrict__ K,const bf16*__restrict__ V,bf16*O,char*shm){
  int tid_=threadIdx.x; asm volatile("":"+v"(tid_));
  const int tid=tid_,lane=tid&63,r32=lane&31,hi=lane>>5; const int wid=__builtin_amdgcn_readfirstlane(tid>>6);
  const long rowbase=(long)b*SEQ; const int q0=qb*QB;
  const bf16*Qw=Q+(rowbase+q0+wid*QBLK)*PITCH+h*D;
  const bf16*Kh=K+rowbase*PITCH+h*D,*Vh=V+rowbase*PITCH+h*D;
  const unsigned lds0=(unsigned)(uintptr_t)shm;
  float*wsf=(float*)(shm+LDS_WS)+wid*64;
  const bf16*ksrc=Kh+(long)lane*PITCH+wid*8;
  const bf16*vsrc=Vh+(long)(16*(wid&3)+(lane>>2))*PITCH+(wid>>2)*32+(lane&3)*8;
  const unsigned kdst=lds0+LDS_K+wid*1024, vdst=lds0+LDS_V+wid*1024;
  const int NT=(q0+QB)/KVBLK;
  #define TILE(t) (((t)<4)?(NT-4+(t)):((t)-4))
  #define DMA_K(t,slot) glds16(ksrc+(long)TILE(t)*KVBLK*PITCH,(unsigned)__builtin_amdgcn_readfirstlane(kdst+(slot)))
  #define DMA_V(t,slot) glds16(vsrc+(long)TILE(t)*KVBLK*PITCH,(unsigned)__builtin_amdgcn_readfirstlane(vdst+(slot)))
  const int vb0=(int)(lds0+LDS_V)+((lane>>4)&1)*32+(lane&3)*8+(4*hi+((lane&15)>>2))*64;
  const char*Kbase=shm+LDS_K; bf16x8 kf[8];
  const lds_cptr shm3=(lds_cptr)shm; const lds_cptr kp0=shm3+LDS_K+hi*1024+r32*16; const lds_cptr vp0=shm3+LDS_V+((lane>>4)&1)*32+(lane&3)*8+(4*hi+((lane&15)>>2))*64;
  DMA_K(0,0);DMA_V(0,0);DMA_K(1,SLOTB);
  bf16x8 qr[4];
  #pragma unroll
  for(int d0=0;d0<4;++d0)qr[d0]=*reinterpret_cast<const bf16x8*>(&Qw[(long)r32*PITCH+d0*16+hi*8]);
  const int qrel=wid*QBLK+r32;
  unsigned selm=0u;
  if constexpr(MODE==0){
    if(qb>0){
      const float*ksm=(const float*)(shm+LDS_KSUM);
      float b0=-INFINITY,b1=-INFINITY,b2=-INFINITY;int i0=-1,i1=-1,i2=-1;
      #pragma unroll 1
      for(int j=0;j<qb;++j){
        const float*kj=ksm+j*64+8*hi; float a0=0.f,a1=0.f;
        #pragma unroll
        for(int d0=0;d0<4;++d0){ const f32x4v x0=*(const f32x4v*)(kj+16*d0),x1=*(const f32x4v*)(kj+16*d0+4);
          #define QF(jj) __uint_as_float(((unsigned)(unsigned short)qr[d0][jj])<<16)
          a0+=QF(0)*x0[0]+QF(1)*x0[1]+QF(2)*x0[2]+QF(3)*x0[3]; a1+=QF(4)*x1[0]+QF(5)*x1[1]+QF(6)*x1[2]+QF(7)*x1[3];
          #undef QF
          asm volatile("":"+v"(a0),"+v"(a1)); }
        float a=a0+a1; { auto rr=__builtin_amdgcn_permlane32_swap(__float_as_uint(a),__float_as_uint(a),false,false); a=__uint_as_float(rr[0])+__uint_as_float(rr[1]); }
        if(a>b0){b2=b1;i2=i1;b1=b0;i1=i0;b0=a;i0=j;} else if(a>b1){b2=b1;i2=i1;b1=a;i1=j;} else if(a>b2){b2=a;i2=j;}
      }
      if(i0>=0)selm|=1u<<i0; if(i1>=0)selm|=1u<<i1; if(i2>=0)selm|=1u<<i2;
    }
  }
  [[maybe_unused]] const lds_cptr lutb=shm3+LDS_LUT+16*(qrel-4*hi+256-56);
  float mhat=0.f,l_reg=0.f;f32x16 o[2];o[0]=f32x16{};o[1]=f32x16{};
  #define KREL(t) (((t)<4)?(64*(t)):(64*((t)-4)-q0))
  #define INIT(P0,P1,t) do{ \
    if constexpr(MODE==0){ float iv_=-mhat; if((t)>=4){ const bool on_=(selm>>(((t)>=4?(t)-4:0)>>2))&1u; iv_=on_?iv_:-INFINITY; } \
      _Pragma("unroll") for(int r=0;r<16;++r){ P0[r]=iv_; P1[r]=iv_; } } \
    else { const lds_cptr lp_=lutb-16*KREL(t); const float nm_=-mhat; \
      _Pragma("unroll") for(int g_=0;g_<4;++g_){ const f32x4v u0_=*(const __attribute__((address_space(3))) f32x4v*)(lp_+16*(56-8*g_)), u1_=*(const __attribute__((address_space(3))) f32x4v*)(lp_+16*(24-8*g_)); \
        P0[4*g_]=u0_[0]+nm_;P0[4*g_+1]=u0_[1]+nm_;P0[4*g_+2]=u0_[2]+nm_;P0[4*g_+3]=u0_[3]+nm_; P1[4*g_]=u1_[0]+nm_;P1[4*g_+1]=u1_[1]+nm_;P1[4*g_+2]=u1_[2]+nm_;P1[4*g_+3]=u1_[3]+nm_; } } \
    asm volatile("":"+v"(P0),"+v"(P1)); }while(0)
  #define FIXUP(P0,P1,t) do{ if constexpr(MODE==0){ if((t)<4){ cmask(P0,P1,(t),qrel,hi); } } }while(0)
  bool resc=false;
  #define START(P0,P1) do{ const float rm=rowmax(P0,P1); resc=false; \
    { const float dl=rm; mhat=fadd_s(mhat,dl); \
      _Pragma("unroll") for(int r=0;r<16;++r){P0[r]=fsub_s(P0[r],dl);P1[r]=fsub_s(P1[r],dl);} } \
    _Pragma("unroll") for(int r=0;r<16;++r)P0[r]=__builtin_amdgcn_exp2f(P0[r]); }while(0)
  #define RESC() do{ if(resc){ asm volatile("s_waitcnt lgkmcnt(0)":::"memory"); \
      _Pragma("unroll") for(int d_=0;d_<2;++d_) _Pragma("unroll") for(int r=0;r<16;++r)o[d_][r]*=wsf[crow(r,hi)]; } }while(0)
  f32x16 pA0,pA1,pB0,pB1;
  int sl_prev=0,sl_cur=0,sl_next=SLOTB;
  #define ROT() do{sl_prev=sl_cur;sl_cur=sl_next;sl_next=(sl_next==(NSLOT-1)*SLOTB)?0:sl_next+SLOTB;}while(0)
  DMA_K(2,2*SLOTB);
  WAIT_BAR(3);
  INIT(pA0,pA1,0); qkt(pA0,pA1,Kbase,qr,r32,hi);asm volatile("s_nop 15\n\ts_nop 7":"+v"(pA0),"+v"(pA1));FIXUP(pA0,pA1,0);
  START(pA0,pA1);
  _Pragma("unroll") for(int r=0;r<16;++r)pA1[r]=__builtin_amdgcn_exp2f(pA1[r]);
  WAIT_BAR(0);
  DMA_K(3,0);DMA_V(1,SLOTB);
  ROT();
  kload8(kf,kp0+sl_cur);
  WAIT_BAR(2);
  s16x4 vlo[8],vhi[8]; u32x4 pw0,pw1,pw2,pw3;
  #define PKW(P,B) cvtpk_s(P[B],P[B+1])
  #define PAF(k) __builtin_bit_cast(bf16x8,pw##k)
  #define VFR(i) (bf16x8){vlo[i][0],vlo[i][1],vlo[i][2],vlo[i][3],vhi[i][0],vhi[i][1],vhi[i][2],vhi[i][3]}
  #define PIN(x) asm volatile("":"+v"(x))
  #define MX3(a,b,c) __builtin_fmaxf(__builtin_fmaxf((a),(b)),(c))
  #define GAPA(MF,A0,A1,A2,A3,W0,W1,PW) do{ MF; sacc+=A0; sacc+=A1; sacc+=A2; sacc+=A3; PIN(sacc); W0; W1; PIN(PW); SBAR(); }while(0)
  #define EX(v) __builtin_amdgcn_exp2f(v)
  #define GAPB(MF,X,B) do{ MF; X[B]=EX(X[B]); X[B+1]=EX(X[B+1]); X[B+2]=EX(X[B+2]); X[B+3]=EX(X[B+3]); PIN(X); SBAR(); }while(0)
  #define VRD(i) do{ vlo[i]=vtr(vp_+(((i)>>2)*4096+((i)&3)*1024)); vhi[i]=vtr(vp_+(((i)>>2)*4096+((i)&3)*1024+512)); }while(0)
  #define KRD(G,j) do{ if(G){ kload2(kf,kp0+sl_next,j); SBAR(); } }while(0)
  #define STEP(C0,C1,P0,P1,t,GK,GV,GL) do{ SBAR(); INIT(C0,C1,t); SBAR(); \
    const lds_cptr vp_=vp0+sl_prev; \
    VRD(0); SBAR(); float sacc=(P0[0]+P0[1]); \
    GAPA(C0=__builtin_amdgcn_mfma_f32_32x32x16_bf16(kf[0],qr[0],C0,0,0,0), P0[2],P0[3],P0[4],P0[5],     pw0[0]=PKW(P0,0), pw0[1]=PKW(P0,2), pw0); \
    VRD(4); SBAR(); GAPA(C1=__builtin_amdgcn_mfma_f32_32x32x16_bf16(kf[1],qr[0],C1,0,0,0), P0[6],P0[7],P0[8],P0[9],     pw0[2]=PKW(P0,4), pw0[3]=PKW(P0,6), pw0); \
    VRD(1); SBAR(); GAPA(C0=__builtin_amdgcn_mfma_f32_32x32x16_bf16(kf[2],qr[1],C0,0,0,0),   P0[10],P0[11],P0[12],P0[13], pw1[0]=PKW(P0,8), pw1[1]=PKW(P0,10), pw1); \
    VRD(5); SBAR(); GAPA(C1=__builtin_amdgcn_mfma_f32_32x32x16_bf16(kf[3],qr[1],C1,0,0,0),   P0[14],P0[15],P1[0],P1[1],   pw1[2]=PKW(P0,12),pw1[3]=PKW(P0,14), pw1); \
    VRD(2); SBAR(); GAPA(C0=__builtin_amdgcn_mfma_f32_32x32x16_bf16(kf[4],qr[2],C0,0,0,0),   P1[2],P1[3],P1[4],P1[5],     pw2[0]=PKW(P1,0), pw2[1]=PKW(P1,2), pw2); \
    VRD(6); SBAR(); GAPA(C1=__builtin_amdgcn_mfma_f32_32x32x16_bf16(kf[5],qr[2],C1,0,0,0),   P1[6],P1[7],P1[8],P1[9],     pw2[2]=PKW(P1,4), pw2[3]=PKW(P1,6), pw2); \
    VRD(3); SBAR(); GAPA(C0=__builtin_amdgcn_mfma_f32_32x32x16_bf16(kf[6],qr[3],C0,0,0,0),   P1[10],P1[11],P1[12],P1[13], pw3[0]=PKW(P1,8), pw3[1]=PKW(P1,10), pw3); \
    VRD(7); SBAR(); GAPA(C1=__builtin_amdgcn_mfma_f32_32x32x16_bf16(kf[7],qr[3],C1,0,0,0),   P1[14],P1[15],0.f,0.f,       pw3[2]=PKW(P1,12),pw3[3]=PKW(P1,14), pw3); \
    l_reg+=sacc; \
    if(GK){DMA_K((t)+3,sl_cur);} if(GV){DMA_V((t)+1,sl_next);} \
    FIXUP(C0,C1,t); \
    { float a=MX3(C0[0],C0[1],C1[0]),b=MX3(C0[2],C0[3],C1[1]); a=MX3(a,C1[2],C1[3]); \
      _Pragma("unroll") for(int r=4;r<16;r+=4){a=MX3(a,C0[r],C0[r+1]);b=MX3(b,C0[r+2],C0[r+3]);a=MX3(a,C1[r],C1[r+1]);b=MX3(b,C1[r+2],C1[r+3]);} \
      float rm=__builtin_fmaxf(a,b); { auto rr=__builtin_amdgcn_permlane32_swap(__float_as_uint(rm),__float_as_uint(rm),false,false); rm=__builtin_fmaxf(__uint_as_float(rr[0]),__uint_as_float(rr[1])); } \
      resc=false; \
      if(__builtin_expect(__any(rm>(float)THRL),0)){ const float dl=__builtin_fmaxf(rm,0.f); mhat+=dl; \
        _Pragma("unroll") for(int r=0;r<16;++r){C0[r]-=dl;C1[r]-=dl;} \
        const float f=__builtin_amdgcn_exp2f(-dl); l_reg*=f; if(hi==0)wsf[r32]=f; resc=true; } } \
    SBAR(); \
    GAPB(o[0]=__builtin_amdgcn_mfma_f32_32x32x16_bf16(PAF(0),VFR(0),o[0],0,0,0), C0,0); \
    GAPB(o[1]=__builtin_amdgcn_mfma_f32_32x32x16_bf16(PAF(0),VFR(4),o[1],0,0,0), C0,4); \
    KRD(GL,0); GAPB(o[0]=__builtin_amdgcn_mfma_f32_32x32x16_bf16(PAF(1),VFR(1),o[0],0,0,0), C0,8); \
    KRD(GL,1); GAPB(o[1]=__builtin_amdgcn_mfma_f32_32x32x16_bf16(PAF(1),VFR(5),o[1],0,0,0), C0,12); \
    KRD(GL,2); GAPB(o[0]=__builtin_amdgcn_mfma_f32_32x32x16_bf16(PAF(2),VFR(2),o[0],0,0,0), C1,0); \
    KRD(GL,3); GAPB(o[1]=__builtin_amdgcn_mfma_f32_32x32x16_bf16(PAF(2),VFR(6),o[1],0,0,0), C1,4); \
    GAPB(o[0]=__builtin_amdgcn_mfma_f32_32x32x16_bf16(PAF(3),VFR(3),o[0],0,0,0), C1,8); \
    GAPB(o[1]=__builtin_amdgcn_mfma_f32_32x32x16_bf16(PAF(3),VFR(7),o[1],0,0,0), C1,12); \
    }while(0)
  #define ENDW(tt) do{ if((tt)+3<NT){WAIT_BAR(2);} else if((tt)+2<NT){WAIT_BAR(1);} else {WAIT_BAR(0);} }while(0)
  int t=1;
  for(;t+1<NT;t+=2){
    STEP(pB0,pB1,pA0,pA1,t,(t+3<NT),(t+1<NT),(t+1<NT));       ENDW(t);   RESC(); ROT();
    STEP(pA0,pA1,pB0,pB1,t+1,(t+4<NT),(t+2<NT),(t+2<NT));     ENDW(t+1); RESC(); ROT();
  }
  STEP(pB0,pB1,pA0,pA1,NT-1,false,false,false); RESC();
  { float sacc=pB0[0]+pB0[1]; _Pragma("unroll") for(int r=2;r<16;++r)sacc+=pB0[r]; _Pragma("unroll") for(int r=0;r<16;++r)sacc+=pB1[r]; l_reg+=sacc;
    pw0=(u32x4){PKW(pB0,0),PKW(pB0,2),PKW(pB0,4),PKW(pB0,6)};pw1=(u32x4){PKW(pB0,8),PKW(pB0,10),PKW(pB0,12),PKW(pB0,14)};pw2=(u32x4){PKW(pB1,0),PKW(pB1,2),PKW(pB1,4),PKW(pB1,6)};pw3=(u32x4){PKW(pB1,8),PKW(pB1,10),PKW(pB1,12),PKW(pB1,14)};
    SBAR(); pv(o,vb0+sl_cur,PAF(0),PAF(1),PAF(2),PAF(3)); }
  #undef PKW
  #undef PAF
  #undef VFR
  #undef PIN
  #undef MX3
  #undef GAPA
  #undef GAPB
  #undef EX
  #undef VRD
  #undef KRD
  #undef STEP
  #undef ENDW
  {auto rr=__builtin_amdgcn_permlane32_swap(__float_as_uint(l_reg),__float_as_uint(l_reg),false,false);l_reg=__uint_as_float(rr[0])+__uint_as_float(rr[1]);}
  if(hi==0)wsf[32+r32]=l_reg;asm volatile("s_waitcnt lgkmcnt(0)":::"memory");
  float rli[16];
  #pragma unroll
  for(int r=0;r<16;++r)rli[r]=__builtin_amdgcn_rcpf(wsf[32+crow(r,hi)]);
  bf16*Ow=O+(rowbase+q0+wid*QBLK)*OPITCH+h*D;
  { bf16*stg=(bf16*)(shm+LDS_OST)+wid*2048;
    #pragma unroll
    for(int r=0;r<16;++r){const int orow=crow(r,hi);
      #pragma unroll
      for(int d0=0;d0<2;++d0)stg[orow*64+d0*32+r32]=(bf16)(cvtpk_s(o[d0][r]*rli[r],0.f)&0xffffu);}
    asm volatile("s_waitcnt lgkmcnt(0)":::"memory");
    #pragma unroll
    for(int i=0;i<4;++i){const int row=i*8+(lane>>3),ch=lane&7; const u32x4 v=*(const u32x4*)(stg+row*64+ch*8); *(u32x4*)(Ow+(long)row*OPITCH+ch*8)=v;} }
  asm volatile("s_waitcnt lgkmcnt(0)\n\ts_barrier":::"memory");
  #undef DMA_K
  #undef DMA_V
  #undef TILE
  #undef KREL
  #undef FIXUP
  #undef INIT
  #undef START
  #undef RESC
  #undef ROT
}
#undef SBAR
#undef WAIT_BAR
}

typedef __attribute__((address_space(4))) const char* karg_ptr;
struct Frame {
    LAS unsigned char* lds;
    volatile LAS unsigned* MISC;
    int tid, lane, wave, vcu, G;
    karg_ptr ka;
    __device__ __forceinline__ const float* inp(int i) const { return *(const float* const __attribute__((address_space(4)))*)(ka + 8 * i); }
    __device__ __forceinline__ float* outp() const { return *(float* const __attribute__((address_space(4)))*)(ka + 8 * 17); }
    __device__ __forceinline__ unsigned char* wsp() const { return *(unsigned char* const __attribute__((address_space(4)))*)(ka + 8 * 18); }
    __device__ __forceinline__ gu32* ctl() const { return (gu32*)(wsp() + WS_CTL); }
    __device__ __forceinline__ bf16_t* XB() const { return (bf16_t*)(wsp() + WS_XB); }
    __device__ __forceinline__ bf16_t* Z() const { return (bf16_t*)(wsp() + WS_Z); }
    __device__ __forceinline__ bf16_t* Y() const { return (bf16_t*)(wsp() + WS_Y); }
    __device__ __forceinline__ float* rss() const { return (float*)(wsp() + WS_RSS); }
    __device__ __forceinline__ float* rinvtok() const { return (float*)(wsp() + WS_RINV); }
    __device__ __forceinline__ float* kpart() const { return (float*)(wsp() + WS_KPART); }
    __device__ __forceinline__ float* grow() const { return (float*)(wsp() + WS_GROW); }
    __device__ __forceinline__ int* tokof() const { return (int*)(wsp() + WS_TOKOF); }
    __device__ __forceinline__ int* tslot() const { return (int*)(wsp() + WS_TSLOT); }
    __device__ __forceinline__ bf16_t* wsgu() const { return (bf16_t*)(wsp() + WS_WSGU); }
};
enum { IN_X = 0, IN_GMIX, IN_WIN, IN_SGULN, IN_SGUW, IN_SGUB, IN_CONVW, IN_WOUT, IN_GFFN, IN_DWG, IN_DWU, IN_DWD, IN_ROUTER, IN_MWG, IN_MWU, IN_MWD, IN_GFINAL };

__device__ __forceinline__ void p0_item(const float* W, int N, const float* g, bf16_t* WT, int K, int drow0, int k0, int n0, LAS float* scr, int lane) {
#pragma unroll 8
    for (int i = 0; i < 32; ++i) { const int kk = 2 * i + (lane >> 5); scr[kk * 33 + (lane & 31)] = W[(size_t)(k0 + kk) * N + n0 + (lane & 31)]; }
    LDS_WAIT(); asm volatile("" ::: "memory");
    const int c = lane & 7;
    f32x4 g0 = (f32x4){1.f, 1.f, 1.f, 1.f}, g1 = g0;
    if (g) { g0 = *(const f32x4*)(g + k0 + 8 * c); g1 = *(const f32x4*)(g + k0 + 8 * c + 4); }
#pragma unroll
    for (int j = 0; j < 4; ++j) { const int n = (lane >> 3) + 8 * j; const LAS float* s = scr + (8 * c) * 33 + n;
        u32x4 o; o.x = cvt_pk_bf16(s[0 * 33] * g0[0], s[1 * 33] * g0[1]); o.y = cvt_pk_bf16(s[2 * 33] * g0[2], s[3 * 33] * g0[3]);
        o.z = cvt_pk_bf16(s[4 * 33] * g1[0], s[5 * 33] * g1[1]); o.w = cvt_pk_bf16(s[6 * 33] * g1[2], s[7 * 33] * g1[3]);
        *(u32x4*)(WT + (size_t)(drow0 + n) * K + k0 + 8 * c) = o; }
    LDS_WAIT(); asm volatile("" ::: "memory");
}
__device__ __forceinline__ void p0_prologue(Frame& F) {
    LAS float* scr = (LAS float*)(F.lds + F.wave * 16384);
    const int gw = F.vcu * NWAVES + F.wave, NGW = F.G * NWAVES;
    constexpr int IT_IN = 16 * 88, IT_OUT = 16 * 32, IT_GU = 16 * 88, IT_DN = 44 * 32;
    constexpr int NA = 2 * IT_IN, NBB = 2 * IT_OUT, NC = 18 * IT_GU, ND = 9 * IT_DN, NITEMS = NA + NBB + NC + ND;
    unsigned char* ws = F.wsp();
    for (int it = gw; it < NITEMS; it += NGW) {
        int r = it;
        if (r < NA) { const int l = r / IT_IN; r %= IT_IN; const int kb = r / 88, nb = r % 88;
            p0_item(F.inp(IN_WIN) + (size_t)l * D * INC, INC, F.inp(IN_GMIX) + l * D, (bf16_t*)(ws + WS_WIN) + (size_t)l * INC * D, D, 32 * nb, 64 * kb, 32 * nb, scr, F.lane); continue; }
        r -= NA;
        if (r < NBB) { const int l = r / IT_OUT; r %= IT_OUT; const int kb = r / 32, nb = r % 32;
            p0_item(F.inp(IN_WOUT) + (size_t)l * D * D, D, nullptr, (bf16_t*)(ws + WS_WOUT) + (size_t)l * D * D, D, 32 * nb, 64 * kb, 32 * nb, scr, F.lane); continue; }
        r -= NBB;
        if (r < NC) { const int mm = r / IT_GU; r %= IT_GU; const int set = mm >> 1, up = mm & 1; const int kb = r / 88, nb = r % 88, n0 = 32 * nb;
            const float* W = set == 0 ? (up ? F.inp(IN_DWU) : F.inp(IN_DWG)) : ((up ? F.inp(IN_MWU) : F.inp(IN_MWG)) + (size_t)(set - 1) * D * FF);
            bf16_t* WT = set == 0 ? (bf16_t*)(ws + WS_WGU0) : (bf16_t*)(ws + WS_MWGU) + (size_t)(set - 1) * GU * D;
            p0_item(W, FF, F.inp(IN_GFFN) + (set == 0 ? 0 : D), WT, D, (n0 >> 7) * 256 + up * 128 + (n0 & 127), 64 * kb, n0, scr, F.lane); continue; }
        r -= NC;
        { const int mm = r / IT_DN; r %= IT_DN; const int kb = r / 32, nb = r % 32;
            const float* W = mm == 0 ? F.inp(IN_DWD) : F.inp(IN_MWD) + (size_t)(mm - 1) * FF * D;
            bf16_t* WT = mm == 0 ? (bf16_t*)(ws + WS_WDN0) : (bf16_t*)(ws + WS_MWDN) + (size_t)(mm - 1) * D * FF;
            p0_item(W, D, nullptr, WT, FF, 32 * nb, 64 * kb, 32 * nb, scr, F.lane); }
    }
    { const float* sw = F.inp(IN_SGUW); bf16_t* wo = F.wsgu();
      for (int idx = (F.vcu * NWAVES + F.wave) * 64 + F.lane; idx < 2 * 4 * 128 * 16; idx += F.G * NWAVES * 64) {
          const int row = idx >> 4, s0 = (idx & 15) * 8, t = row & 127;
          const f32x4 a = *(const f32x4*)(sw + (size_t)row * 128 + s0), b = *(const f32x4*)(sw + (size_t)row * 128 + s0 + 4);
          float v[8] = {a[0], a[1], a[2], a[3], b[0], b[1], b[2], b[3]};
#pragma unroll
          for (int e = 0; e < 8; ++e) if (s0 + e > t) v[e] = 0.f;
          u32x4 w; w.x = cvt_pk_bf16(v[0], v[1]); w.y = cvt_pk_bf16(v[2], v[3]); w.z = cvt_pk_bf16(v[4], v[5]); w.w = cvt_pk_bf16(v[6], v[7]);
          *(u32x4*)(wo + (size_t)row * 128 + s0) = w; } }
    const float* x = F.inp(IN_X);
    for (int m = gw; m < T; m += NGW) {
        const f32x4* xr = (const f32x4*)(x + (size_t)m * D) + F.lane; float s = 0.f; u32x2* o8 = (u32x2*)(F.XB() + (size_t)m * D) + F.lane;
#pragma unroll
        for (int j = 0; j < 4; ++j) { const f32x4 v = xr[64 * j]; s += (v[0] * v[0] + v[1] * v[1]) + (v[2] * v[2] + v[3] * v[3]); u32x2 w; w.x = cvt_pk_bf16(v[0], v[1]); w.y = cvt_pk_bf16(v[2], v[3]); o8[64 * j] = w; }
        s = wave_sum(s);
        if (F.lane < 4) F.rss()[(size_t)F.lane * T + m] = F.lane == 0 ? s : 0.f;
    }
}

__device__ __forceinline__ void attn_simple_unit(Frame& F, int mode, int b, int h, int qb) {
    LAS float* Ks = (LAS float*)(F.lds);
    LAS float* Vs = Ks + 4096;
    LAS float* ksm = Vs + 4096;
    const int tid = F.tid, row = tid & 255, dh = tid >> 8;
    const int qoff = mode ? 2048 : 0, ycol = mode ? 768 : 0;
    const int tq = qb * 256 + row;
    const size_t tok = (size_t)b * SEQ + tq;
    float q[64];
    { const u32x4* qp = (const u32x4*)(F.Z() + tok * INC + qoff + h * 64);
#pragma unroll
      for (int i = 0; i < 8; ++i) { const u32x4 w = qp[i]; q[8 * i + 0] = bf_lo(w.x); q[8 * i + 1] = bf_hi(w.x); q[8 * i + 2] = bf_lo(w.y); q[8 * i + 3] = bf_hi(w.y); q[8 * i + 4] = bf_lo(w.z); q[8 * i + 5] = bf_hi(w.z); q[8 * i + 6] = bf_lo(w.w); q[8 * i + 7] = bf_hi(w.w); } }
    unsigned sel = 0u;
    __syncthreads();
    if (mode == 0) {
        { const int j = tid >> 6, d = tid & 63; float v = 0.f; if (j < qb) { const float* kp = F.kpart() + ((size_t)(b * 8 + j) * 2) * 256 + h * 64 + d; v = kp[0] + kp[256]; } ksm[tid] = v; }
        __syncthreads();
        float b0 = -INFINITY, b1 = -INFINITY, b2 = -INFINITY; int i0 = -1, i1 = -1, i2 = -1;
#pragma unroll 1
        for (int j = 0; j < qb; ++j) { float a0 = 0.f, a1 = 0.f, a2 = 0.f, a3 = 0.f; const LAS float* kj = ksm + j * 64;
#pragma unroll
            for (int d = 0; d < 64; d += 4) { const f32x4 kv = *(const LAS f32x4*)(kj + d); a0 += q[d] * kv[0]; a1 += q[d + 1] * kv[1]; a2 += q[d + 2] * kv[2]; a3 += q[d + 3] * kv[3]; }
            const float a = (a0 + a1) + (a2 + a3);
            if (a > b0) { b2 = b1; i2 = i1; b1 = b0; i1 = i0; b0 = a; i0 = j; } else if (a > b1) { b2 = b1; i2 = i1; b1 = a; i1 = j; } else if (a > b2) { b2 = a; i2 = j; } }
        if (i0 >= 0) sel |= 1u << i0; if (i1 >= 0) sel |= 1u << i1; if (i2 >= 0) sel |= 1u << i2;
    }
    float mx = -INFINITY, l = 0.f; float o[32];
#pragma unroll
    for (int d = 0; d < 32; ++d) o[d] = 0.f;
    const int ntl = 4 * (qb + 1);
#pragma unroll 1
    for (int tl = 0; tl < ntl; ++tl) {
        __syncthreads();
        { const int r = tid >> 3, ch = tid & 7; const bf16_t* kr = F.Z() + ((size_t)b * SEQ + tl * 64 + r) * INC + qoff + h * 64 + ch * 8;
          const u32x4 kw = *(const u32x4*)(kr + 256), vw = *(const u32x4*)(kr + 512);
          *(LAS f32x4*)(Ks + r * 64 + ch * 8) = (f32x4){bf_lo(kw.x), bf_hi(kw.x), bf_lo(kw.y), bf_hi(kw.y)}; *(LAS f32x4*)(Ks + r * 64 + ch * 8 + 4) = (f32x4){bf_lo(kw.z), bf_hi(kw.z), bf_lo(kw.w), bf_hi(kw.w)};
          *(LAS f32x4*)(Vs + r * 64 + ch * 8) = (f32x4){bf_lo(vw.x), bf_hi(vw.x), bf_lo(vw.y), bf_hi(vw.y)}; *(LAS f32x4*)(Vs + r * 64 + ch * 8 + 4) = (f32x4){bf_lo(vw.z), bf_hi(vw.z), bf_lo(vw.w), bf_hi(vw.w)}; }
        __syncthreads();
        const int jblk = tl >> 2;
        const bool tile_on = (mode != 0) || (jblk == qb) || ((sel >> jblk) & 1u);
#pragma unroll 1
        for (int key = 0; key < 64; ++key) {
            const int dist = tq - (tl * 64 + key);
            float bias = 0.f; bool valid;
            if (mode == 0) valid = tile_on && (jblk != qb || dist >= 0);
            else { int c = 0; if (dist >= 0) c = (dist <= 128 ? 1 : 0) + ((((dist & 3) == 0) && dist <= 512) ? 1 : 0) + (((dist & 15) == 0) ? 1 : 0);
                   valid = c > 0; bias = c == 3 ? 1.5849625007211562f : (c == 2 ? 1.f : 0.f); }
            if (valid) {
                const LAS float* kr = Ks + key * 64; float s0 = bias, s1 = 0.f, s2 = 0.f, s3 = 0.f;
#pragma unroll
                for (int d = 0; d < 64; d += 4) { const f32x4 kv = *(const LAS f32x4*)(kr + d); s0 += q[d] * kv[0]; s1 += q[d + 1] * kv[1]; s2 += q[d + 2] * kv[2]; s3 += q[d + 3] * kv[3]; }
                const float s = (s0 + s1) + (s2 + s3);
                if (s > mx) { const float a = fast_exp2(mx - s); l *= a;
#pragma unroll
                    for (int d = 0; d < 32; ++d) o[d] *= a;
                    mx = s; }
                const float p = fast_exp2(s - mx); l += p; const LAS float* vr = Vs + key * 64 + dh * 32;
#pragma unroll
                for (int d = 0; d < 32; d += 4) { const f32x4 vv = *(const LAS f32x4*)(vr + d); o[d] += p * vv[0]; o[d + 1] += p * vv[1]; o[d + 2] += p * vv[2]; o[d + 3] += p * vv[3]; }
            }
        }
    }
    { const float inv = 1.f / l;
      u32x4* yp = (u32x4*)(F.Y() + tok * D + ycol + h * 64 + dh * 32);
#pragma unroll
      for (int i = 0; i < 4; ++i) { u32x4 w; w.x = cvt_pk_bf16(o[8 * i] * inv, o[8 * i + 1] * inv); w.y = cvt_pk_bf16(o[8 * i + 2] * inv, o[8 * i + 3] * inv); w.z = cvt_pk_bf16(o[8 * i + 4] * inv, o[8 * i + 5] * inv); w.w = cvt_pk_bf16(o[8 * i + 6] * inv, o[8 * i + 7] * inv); yp[i] = w; } }
    __syncthreads();
}
__device__ __forceinline__ void sgu_simple_item(Frame& F, int l, int item) {
    LAS float* vn = (LAS float*)(F.lds);
    const int tok0 = item * 128;
    const float* lng = F.inp(IN_SGULN) + l * 256;
    __syncthreads();
    for (int t = F.wave; t < 128; t += NWAVES) {
        const bf16_t* zr = F.Z() + (size_t)(tok0 + t) * INC + 1024 + 4 * F.lane; const u32x2 w = *(const u32x2*)zr;
        float v[4] = {gelu_tanh(bf_lo(w.x)), gelu_tanh(bf_hi(w.x)), gelu_tanh(bf_lo(w.y)), gelu_tanh(bf_hi(w.y))};
        const float mean = wave_sum((v[0] + v[1]) + (v[2] + v[3])) * (1.f / 256.f);
        float s2 = 0.f;
#pragma unroll
        for (int e = 0; e < 4; ++e) { v[e] -= mean; s2 += v[e] * v[e]; }
        const float rstd = __builtin_amdgcn_rsqf(wave_sum(s2) * (1.f / 256.f) + LN_EPS);
        const f32x4 gg = *(const f32x4*)(lng + 4 * F.lane);
        *(LAS f32x4*)(vn + t * 256 + 4 * F.lane) = (f32x4){v[0] * rstd * gg[0], v[1] * rstd * gg[1], v[2] * rstd * gg[2], v[3] * rstd * gg[3]};
    }
    __syncthreads();
    const int c = F.tid & 255, th = F.tid >> 8, g = c >> 6;
    const float* Wg = F.inp(IN_SGUW) + ((size_t)l * 4 + g) * 128 * 128;
    const float* bs = F.inp(IN_SGUB) + ((size_t)l * 4 + g) * 128;
    for (int tt = 0; tt < 64; ++tt) {
        const int t = th * 64 + tt; const float* wrow = Wg + t * 128; float a = 0.f;
        for (int s = 0; s <= t; ++s) a += wrow[s] * vn[s * 256 + c];
        const size_t tok = (size_t)tok0 + t;
        const float u = gelu_tanh(bf_lo((unsigned)F.Z()[tok * INC + 768 + c]));
        const float y = u * (a + bs[t]);
        F.Y()[tok * D + 256 + c] = (bf16_t)(cvt_pk_bf16(y, 0.f) & 0xffffu);
    }
    __syncthreads();
}
__device__ __forceinline__ void conv_simple_item(Frame& F, int l, int item) {
    const int c = F.tid & 255, th = F.tid >> 8; const int tok0 = item * 64 + th * 32;
    const float* cw = F.inp(IN_CONVW) + (size_t)l * 3 * 256;
    const float w0 = cw[c], w1 = cw[256 + c], w2 = cw[512 + c];
    float zm2 = 0.f, zm1 = 0.f;
    const int p0 = tok0 & (SEQ - 1);
    if (p0 >= 2) { const bf16_t* z = F.Z() + (size_t)(tok0 - 2) * INC; zm2 = bf_lo((unsigned)z[1536 + c]) * bf_lo((unsigned)z[1792 + c]); }
    if (p0 >= 1) { const bf16_t* z = F.Z() + (size_t)(tok0 - 1) * INC; zm1 = bf_lo((unsigned)z[1536 + c]) * bf_lo((unsigned)z[1792 + c]); }
    for (int t = 0; t < 32; ++t) {
        const bf16_t* z = F.Z() + (size_t)(tok0 + t) * INC;
        const float zc = bf_lo((unsigned)z[1536 + c]) * bf_lo((unsigned)z[1792 + c]);
        const float y = bf_lo((unsigned)z[1280 + c]) * (w0 * zm2 + w1 * zm1 + w2 * zc);
        F.Y()[(size_t)(tok0 + t) * D + 512 + c] = (bf16_t)(cvt_pk_bf16(y, 0.f) & 0xffffu);
        zm2 = zm1; zm1 = zc;
    }
}
typedef float f32x16m __attribute__((ext_vector_type(16)));
__device__ __forceinline__ void sgu_item(Frame& F, int l, int hitem) {
    const int item = hitem >> 1, gp = hitem & 1;
    LAS bf16_t* vnT = (LAS bf16_t*)(F.lds);
    const int tok0 = item * 128;
    const bf16_t* Z = F.Z(); bf16_t* Y = F.Y();
    __syncthreads();
    { const int t = F.tid >> 2, qd = F.tid & 3;
      const u32x4* zp = (const u32x4*)(Z + (size_t)(tok0 + t) * INC + 1024 + 64 * qd);
      float v[64]; float sm = 0.f;
#pragma unroll
      for (int i = 0; i < 8; ++i) { const u32x4 w = zp[i];
          v[8 * i + 0] = gelu_tanh(bf_lo(w.x)); v[8 * i + 1] = gelu_tanh(bf_hi(w.x)); v[8 * i + 2] = gelu_tanh(bf_lo(w.y)); v[8 * i + 3] = gelu_tanh(bf_hi(w.y));
          v[8 * i + 4] = gelu_tanh(bf_lo(w.z)); v[8 * i + 5] = gelu_tanh(bf_hi(w.z)); v[8 * i + 6] = gelu_tanh(bf_lo(w.w)); v[8 * i + 7] = gelu_tanh(bf_hi(w.w));
#pragma unroll
          for (int e = 0; e < 8; ++e) sm += v[8 * i + e]; }
      sm += __shfl_xor(sm, 1); sm += __shfl_xor(sm, 2);
      const float mean = sm * (1.f / 256.f); float s2 = 0.f;
#pragma unroll
      for (int i = 0; i < 64; ++i) { v[i] -= mean; s2 += v[i] * v[i]; }
      s2 += __shfl_xor(s2, 1); s2 += __shfl_xor(s2, 2);
      const float rstd = __builtin_amdgcn_rsqf(s2 * (1.f / 256.f) + LN_EPS);
      if ((qd >> 1) == gp) { const float* lng = F.inp(IN_SGULN) + l * 256 + 64 * qd; LAS bf16_t* dst = vnT + (size_t)(64 * (qd & 1)) * 136 + t;
#pragma unroll
          for (int i = 0; i < 64; i += 4) { const f32x4 gg = *(const f32x4*)(lng + i);
#pragma unroll
              for (int e = 0; e < 4; ++e) dst[(i + e) * 136] = (bf16_t)(cvt_pk_bf16(v[i + e] * rstd * gg[e], 0.f) & 0xffffu); } }
    }
    __syncthreads();
    { const int gl = F.wave >> 2, th = (F.wave >> 1) & 1, cn = F.wave & 1, g = 2 * gp + gl;
      const int r32 = F.lane & 31, hi = F.lane >> 5;
      const bf16_t* Wg = F.wsgu() + ((size_t)(l * 4 + g) * 128) * 128;
      f32x16m acc[2];
#pragma unroll
      for (int tm = 0; tm < 2; ++tm) {
          const int t0 = 64 * th + 32 * tm; f32x16m a = {};
          const int nks = (t0 + 32) >> 4;
          const bf16_t* wrow = Wg + (size_t)(t0 + r32) * 128 + 8 * hi;
          const LAS bf16_t* vrow = vnT + (size_t)(64 * gl + 32 * cn + r32) * 136 + 8 * hi;
#pragma unroll 2
          for (int ks = 0; ks < nks; ++ks) { const bf16x8 af = *(const bf16x8*)(wrow + 16 * ks); const bf16x8 bfr = *(const LAS bf16x8*)(vrow + 16 * ks);
              a = __builtin_amdgcn_mfma_f32_32x32x16_bf16(af, bfr, a, 0, 0, 0); }
          acc[tm] = a; }
      const int c = 64 * g + 32 * cn + r32;
      const float* bs = F.inp(IN_SGUB) + (size_t)(l * 4 + g) * 128;
#pragma unroll
      for (int tm = 0; tm < 2; ++tm)
#pragma unroll
          for (int r = 0; r < 16; ++r) { const int t = 64 * th + 32 * tm + (r & 3) + 8 * (r >> 2) + 4 * hi; const size_t tok = (size_t)tok0 + t;
              const float u = gelu_tanh(bf_lo((unsigned)Z[tok * INC + 768 + c]));
              const float y = u * (acc[tm][r] + bs[t]);
              Y[tok * D + 256 + c] = (bf16_t)(cvt_pk_bf16(y, 0.f) & 0xffffu); }
    }
    __syncthreads();
}
__device__ __forceinline__ void conv_item(Frame& F, int l, int item) {
    const int cg = F.tid & 31, ts = F.tid >> 5; const int tok0 = item * 64 + ts * 4, c0 = 8 * cg;
    const bf16_t* Z = F.Z(); bf16_t* Y = F.Y();
    const float* cw = F.inp(IN_CONVW) + (size_t)l * 3 * 256 + c0;
    float w0[8], w1[8], w2[8];
#pragma unroll
    for (int h = 0; h < 2; ++h) { const f32x4 a = *(const f32x4*)(cw + 4 * h), b = *(const f32x4*)(cw + 256 + 4 * h), c = *(const f32x4*)(cw + 512 + 4 * h);
#pragma unroll
        for (int e = 0; e < 4; ++e) { w0[4 * h + e] = a[e]; w1[4 * h + e] = b[e]; w2[4 * h + e] = c[e]; } }
    float zm2[8], zm1[8];
    const int p0 = tok0 & (SEQ - 1);
#define CONV_LOAD8(dst, ptr) do { const u32x4 w_ = *(const u32x4*)(ptr); dst[0] = bf_lo(w_.x); dst[1] = bf_hi(w_.x); dst[2] = bf_lo(w_.y); dst[3] = bf_hi(w_.y); dst[4] = bf_lo(w_.z); dst[5] = bf_hi(w_.z); dst[6] = bf_lo(w_.w); dst[7] = bf_hi(w_.w); } while (0)
#pragma unroll
    for (int e = 0; e < 8; ++e) { zm2[e] = 0.f; zm1[e] = 0.f; }
    if (p0 >= 2) { float a[8], b[8]; const bf16_t* z = Z + (size_t)(tok0 - 2) * INC + c0; CONV_LOAD8(a, z + 1536); CONV_LOAD8(b, z + 1792);
#pragma unroll
        for (int e = 0; e < 8; ++e) zm2[e] = a[e] * b[e]; }
    if (p0 >= 1) { float a[8], b[8]; const bf16_t* z = Z + (size_t)(tok0 - 1) * INC + c0; CONV_LOAD8(a, z + 1536); CONV_LOAD8(b, z + 1792);
#pragma unroll
        for (int e = 0; e < 8; ++e) zm1[e] = a[e] * b[e]; }
#pragma unroll
    for (int t = 0; t < 4; ++t) { float a[8], b[8], bg[8], y[8]; const bf16_t* z = Z + (size_t)(tok0 + t) * INC + c0; CONV_LOAD8(a, z + 1536); CONV_LOAD8(b, z + 1792); CONV_LOAD8(bg, z + 1280);
#pragma unroll
        for (int e = 0; e < 8; ++e) { const float zc = a[e] * b[e]; y[e] = bg[e] * (w0[e] * zm2[e] + w1[e] * zm1[e] + w2[e] * zc); zm2[e] = zm1[e]; zm1[e] = zc; }
        u32x4 w; w.x = cvt_pk_bf16(y[0], y[1]); w.y = cvt_pk_bf16(y[2], y[3]); w.z = cvt_pk_bf16(y[4], y[5]); w.w = cvt_pk_bf16(y[6], y[7]);
        *(u32x4*)(Y + (size_t)(tok0 + t) * D + 512 + c0) = w; }
#undef CONV_LOAD8
}
#ifndef MIXP
#define MIXP 7
#endif
#ifndef SIMPLE_SGU
#define SIMPLE_SGU 0
#endif
#ifndef SIMPLE_ATTN
#define SIMPLE_ATTN 0
#endif
__device__ __forceinline__ void mixers_phase(Frame& F, int l, char* shm) {
    if (MIXP & 1) for (int v = F.vcu; v < 256; v += F.G) {
        const int mode = v >> 7, bh = (v & 127) >> 2, s = v & 3, b = bh >> 2, h = bh & 3;
#if SIMPLE_ATTN
        attn_simple_unit(F, mode, b, h, s);
        attn_simple_unit(F, mode, b, h, 7 - s);
#else
        const bf16_t* Z = F.Z(); bf16_t* Y = F.Y();
#ifndef ATTN_MODES
#define ATTN_MODES 3
#endif
        if (mode == 0 && (ATTN_MODES & 1)) {
            attn_body::stage_ksum(shm, F.kpart(), b, h);
#pragma unroll 1
            for (int i = 0; i < 2; ++i) attn_body::attn_unit<0, 8>(b, h, i == 0 ? 7 - s : s, Z, Z + 256, Z + 512, Y, shm);
        } else if (ATTN_MODES & 2) {
            attn_body::build_dil_lut(shm);
#pragma unroll 1
            for (int i = 0; i < 2; ++i) attn_body::attn_unit<1, 8>(b, h, i == 0 ? 7 - s : s, Z + 2048, Z + 2304, Z + 2560, Y + 768, shm);
        }
#endif
    }
#if SIMPLE_SGU
    if (MIXP & 2) for (int it = F.vcu; it < 128; it += F.G) sgu_simple_item(F, l, it);
    if (MIXP & 4) for (int it = F.vcu; it < 256; it += F.G) conv_simple_item(F, l, it);
#else
    if (MIXP & 2) for (int it = F.vcu; it < 256; it += F.G) sgu_item(F, l, it);
    if (MIXP & 4) for (int it = F.vcu; it < 256; it += F.G) conv_item(F, l, it);
#endif
}

__device__ __forceinline__ void router_phase(Frame& F) {
    LAS int* pe = (LAS int*)(F.lds);
    LAS float* pg = (LAS float*)(F.lds + 512);
    const float* x1 = F.outp(); const float* gf = F.inp(IN_GFFN) + D; const float* rw = F.inp(IN_ROUTER);
    f32x4 w0[16], w1[16];
#pragma unroll
    for (int j = 0; j < 4; ++j)
#pragma unroll
        for (int e = 0; e < 4; ++e) { const int k = 4 * F.lane + 256 * j + e; const float g = gf[k]; w0[4 * j + e] = *(const f32x4*)(rw + (size_t)k * 8) * g; w1[4 * j + e] = *(const f32x4*)(rw + (size_t)k * 8 + 4) * g; }
    for (int grp = F.vcu; grp < T / 64; grp += F.G) {
        __syncthreads();
        for (int i = 0; i < 8; ++i) {
            const int tl = F.wave * 8 + i, tok = grp * 64 + tl;
            const f32x4* xr = (const f32x4*)(x1 + (size_t)tok * D) + F.lane;
            f32x4 a0 = (f32x4){0.f, 0.f, 0.f, 0.f}, a1 = a0; float ss = 0.f;
#pragma unroll
            for (int j = 0; j < 4; ++j) { const f32x4 v = xr[64 * j]; ss += (v[0] * v[0] + v[1] * v[1]) + (v[2] * v[2] + v[3] * v[3]);
#pragma unroll
                for (int e = 0; e < 4; ++e) { a0 += w0[4 * j + e] * v[e]; a1 += w1[4 * j + e] * v[e]; } }
            ss = wave_sum(ss); const float ri = __builtin_amdgcn_rsqf(ss * (1.f / D) + RMS_EPS);
            float lg[8];
#pragma unroll
            for (int e = 0; e < 4; ++e) { lg[e] = wave_sum(a0[e]) * ri; lg[4 + e] = wave_sum(a1[e]) * ri; }
            int e0 = 0; float v0 = lg[0];
#pragma unroll
            for (int e = 1; e < 8; ++e) if (lg[e] > v0) { v0 = lg[e]; e0 = e; }
            int e1 = -1; float v1 = -INFINITY;
#pragma unroll
            for (int e = 0; e < 8; ++e) if (e != e0 && lg[e] > v1) { v1 = lg[e]; e1 = e; }
            const float g0 = 1.f / (1.f + __expf(v1 - v0)), g1 = 1.f - g0;
            if (F.lane == 0) { pe[2 * tl] = e0; pe[2 * tl + 1] = e1; pg[2 * tl] = g0; pg[2 * tl + 1] = g1; F.rinvtok()[tok] = ri; }
        }
        __syncthreads();
        if (F.wave == 0) {
            const int elo = pe[F.lane], ehi = pe[64 + F.lane]; const float glo = pg[F.lane], ghi = pg[64 + F.lane];
            const unsigned long long ltm = (1ull << F.lane) - 1ull;
            int rlo = 0, rhi = 0, mycnt = 0;
#pragma unroll
            for (int e = 0; e < 8; ++e) { const unsigned long long mlo = __ballot(elo == e), mhi = __ballot(ehi == e); const int clo = __popcll(mlo);
                if (elo == e) rlo = __popcll(mlo & ltm); if (ehi == e) rhi = clo + __popcll(mhi & ltm); if (F.lane == e) mycnt = clo + __popcll(mhi); }
            int mybase = 0;
            if (F.lane < 8) mybase = (int)__hip_atomic_fetch_add((unsigned*)(F.ctl() + CW_CNT + F.lane), (unsigned)mycnt, RLX_AGENT);
            const int blo = __shfl(mybase, elo), bhi = __shfl(mybase, ehi);
            const int slo = elo * 16384 + blo + rlo, shi = ehi * 16384 + bhi + rhi;
            const int toklo = grp * 64 + (F.lane >> 1), tokhi = grp * 64 + 32 + (F.lane >> 1);
            F.tokof()[slo] = toklo; F.grow()[slo] = glo; F.tslot()[2 * toklo + (F.lane & 1)] = slo;
            F.tokof()[shi] = tokhi; F.grow()[shi] = ghi; F.tslot()[2 * tokhi + (F.lane & 1)] = shi;
        }
    }
}
__device__ __forceinline__ void moe_counts(Frame& F, int (&pb)[8], int (&cn)[8], int& nrb) {
    int acc = 0;
#pragma unroll
    for (int e = 0; e < 8; ++e) { const int c = (int)__builtin_amdgcn_readfirstlane(__hip_atomic_load((unsigned*)(F.ctl() + CW_CNT + e), RLX_AGENT)); cn[e] = c; pb[e] = acc; acc += (c + 255) >> 8; }
    nrb = acc;
}
__device__ __forceinline__ void final_phase(Frame& F) {
    int pb[8], cn[8], nrb; moe_counts(F, pb, cn, nrb);
    const bf16_t* YB = (const bf16_t*)(F.wsp() + WS_YB); const float* gfin = F.inp(IN_GFINAL);
    const int gw = F.vcu * NWAVES + F.wave, NGW = F.G * NWAVES;
    for (int m = gw; m < T; m += NGW) {
        const int s0 = F.tslot()[2 * m], s1 = F.tslot()[2 * m + 1];
        int r0 = s0 & 16383, r1 = s1 & 16383; const int e0 = s0 >> 14, e1 = s1 >> 14;
#pragma unroll
        for (int e = 0; e < 8; ++e) { if (e0 == e) r0 += pb[e] * 256; if (e1 == e) r1 += pb[e] * 256; }
        f32x4* xr = (f32x4*)(F.outp() + (size_t)m * D) + F.lane;
        const u32x2* y0 = (const u32x2*)(YB + (size_t)r0 * D) + F.lane; const u32x2* y1 = (const u32x2*)(YB + (size_t)r1 * D) + F.lane;
        f32x4 v[4]; float ss = 0.f;
#pragma unroll
        for (int j = 0; j < 4; ++j) { const u32x2 a = y0[64 * j], b = y1[64 * j]; f32x4 t = xr[64 * j];
            t[0] += bf_lo(a.x) + bf_lo(b.x); t[1] += bf_hi(a.x) + bf_hi(b.x); t[2] += bf_lo(a.y) + bf_lo(b.y); t[3] += bf_hi(a.y) + bf_hi(b.y);
            v[j] = t; ss += (t[0] * t[0] + t[1] * t[1]) + (t[2] * t[2] + t[3] * t[3]); }
        const float ri = __builtin_amdgcn_rsqf(wave_sum(ss) * (1.f / D) + RMS_EPS);
#pragma unroll
        for (int j = 0; j < 4; ++j) { const f32x4 g = *((const f32x4*)gfin + F.lane + 64 * j); xr[64 * j] = v[j] * ri * g; }
    }
}

__device__ __forceinline__ void refresh(Frame& F) { int t = threadIdx.x; asm volatile("" : "+v"(t)); F.tid = t; F.lane = t & 63; }
__device__ __forceinline__ int opaque_s(int v) { asm volatile("" : "+s"(v)); return v; }
struct Args { const float* in[17]; float* out; unsigned char* ws; int ph_lo, ph_hi; };
__global__ void __launch_bounds__(NWAVES * 64, 2) trunk_fwd(Args args) {
    extern __shared__ __attribute__((aligned(16))) unsigned char lds[];
    Frame F;
    F.lds = (LAS unsigned char*)lds;
    F.MISC = (volatile LAS unsigned*)(F.lds + MISC_OFF);
    F.tid = threadIdx.x; F.lane = F.tid & 63; F.wave = __builtin_amdgcn_readfirstlane(F.tid >> 6);
    F.G = gridDim.x; { const int bx = blockIdx.x; F.vcu = (F.G % 8 == 0) ? (bx % 8) * (F.G / 8) + bx / 8 : bx; }
    F.ka = (karg_ptr)__builtin_amdgcn_kernarg_segment_ptr();
    for (int u = F.tid; u < (LDS_BYTES - LDSCTL_OFF) / 4; u += NWAVES * 64) ((LAS unsigned*)(F.lds + LDSCTL_OFF))[u] = 0u;
    __syncthreads();
    XcdBarrier bar; bar.bar = (unsigned*)(F.ctl() + CW_BAR); bar.x = 0; bar.st = nullptr;
    if (MK_N_LAUNCHES == 1) bar = xcd_barrier_post((unsigned*)(F.ctl() + CW_BAR), F.MISC + 8);
#define GRID_BAR() do { if (MK_N_LAUNCHES == 1) xcd_barrier(bar); } while (0)
    const int lo = *(const int __attribute__((address_space(4)))*)(F.ka + 152), hi = *(const int __attribute__((address_space(4)))*)(F.ka + 156);
    (void)args;
#define IN(k) (lo <= (k) && (k) < hi)
#define BOTH(k) (IN(k) && IN((k) + 1))
    PG8_LAS unsigned char* glds = (PG8_LAS unsigned char*)F.lds;
    const int bx = (int)blockIdx.x;

    asm volatile("; MARK P0");
    if (PHC(0) && IN(0)) { refresh(F); p0_prologue(F); if (BOTH(0)) GRID_BAR(); }
    for (int l = 0; l < 2; ++l) {
        const int pbase = 1 + 5 * l;
        asm volatile("; MARK IN_GEMM");
        if (PHC(1) && IN(pbase)) {
            pg8::StaticOrder S; S.init(F.XB(), (const bf16_t*)(F.wsp() + WS_WIN) + (size_t)l * INC * D, T, INC, D, F.G, opaque_s(bx));
            pg8::EpiIn E{F.Z(), F.rss(), F.kpart()};
            pg8::gemm_phase<pg8::EpiIn, pg8::StaticOrder, true, true>(glds, D, S, E);
            if (BOTH(pbase)) GRID_BAR();
        }
        asm volatile("; MARK MIXERS");
        if (PHC(2) && IN(pbase + 1)) { refresh(F); mixers_phase(F, l, (char*)lds); if (BOTH(pbase + 1)) GRID_BAR(); }
        asm volatile("; MARK OUT_GEMM");
        if (PHC(3) && IN(pbase + 2)) {
            pg8::StaticOrder S; S.init(F.Y(), (const bf16_t*)(F.wsp() + WS_WOUT) + (size_t)l * D * D, T, D, D, F.G, opaque_s(bx));
            pg8::EpiRes E{l == 0 ? F.inp(IN_X) : F.outp(), F.outp(), F.XB(), F.rss()};
            if (F.G == 256) pg8::gemm_phase<pg8::EpiRes, pg8::StaticOrder, false, true>(glds, D, S, E);
            if (BOTH(pbase + 2)) GRID_BAR();
        }
        if (l == 0) {
            asm volatile("; MARK DENSE_GU");
            if (PHC(4) && IN(4)) {
                pg8::StaticOrder S; S.init(F.XB(), (const bf16_t*)(F.wsp() + WS_WGU0), T, GU, D, F.G, opaque_s(bx));
                pg8::EpiGU E{(bf16_t*)(F.wsp() + WS_H), F.rss()};
                pg8::gemm_phase<pg8::EpiGU, pg8::StaticOrder, true, true>(glds, D, S, E);
                if (BOTH(4)) GRID_BAR();
            }
            asm volatile("; MARK DENSE_DN");
            if (PHC(5) && IN(5)) {
                pg8::StaticOrder S; S.init((const bf16_t*)(F.wsp() + WS_H), (const bf16_t*)(F.wsp() + WS_WDN0), T, D, FF, F.G, opaque_s(bx));
                pg8::EpiRes E{F.outp(), F.outp(), F.XB(), F.rss()};
                if (F.G == 256) pg8::gemm_phase<pg8::EpiRes, pg8::StaticOrder, false, true>(glds, FF, S, E);
                if (BOTH(5)) GRID_BAR();
            }
        }
    }
    asm volatile("; MARK ROUTER");
    if (PHC(6) && IN(9)) { refresh(F); router_phase(F); if (BOTH(9)) GRID_BAR(); }
    asm volatile("; MARK MOE_GU");
    if (PHC(7) && IN(10)) {
        pg8::MoeGatherOrder S; int nrb; moe_counts(F, S.pb, S.cn, nrb);
        S.nM = nrb; S.nN = GU / 256; S.G = F.G; S.c = opaque_s(bx); S.A = (const char*)F.XB(); S.Bt = (const char*)(F.wsp() + WS_MWGU); S.tstep = (size_t)256 * D * 2; S.estride = (size_t)GU * D * 2; S.tokof = F.tokof();
        pg8::EpiGUMoe E{(bf16_t*)(F.wsp() + WS_MH), F.rinvtok(), F.tokof()};
        pg8::gemm_phase<pg8::EpiGUMoe, pg8::MoeGatherOrder, true, true>(glds, D, S, E);
        if (BOTH(10)) GRID_BAR();
    }
    asm volatile("; MARK MOE_DN");
    if (PHC(8) && IN(11)) {
        pg8::MoePlainOrder S; int nrb; moe_counts(F, S.pb, S.cn, nrb);
        S.nM = nrb; S.nN = D / 256; S.G = F.G; S.c = opaque_s(bx); S.A = (const char*)(F.wsp() + WS_MH); S.Bt = (const char*)(F.wsp() + WS_MWDN); S.tstep = (size_t)256 * FF * 2; S.estride = (size_t)D * FF * 2; S.tokof = F.tokof();
        pg8::EpiDnMoe E{(bf16_t*)(F.wsp() + WS_YB), F.grow()};
        pg8::gemm_phase<pg8::EpiDnMoe, pg8::MoePlainOrder, true, true>(glds, FF, S, E);
        if (BOTH(11)) GRID_BAR();
    }
    asm volatile("; MARK FINAL");
    if (PHC(9) && IN(12)) { refresh(F); final_phase(F); }
#undef IN
#undef BOTH
#undef GRID_BAR
}

extern "C" void kernel_launch(void* const* d_in, const int* in_sizes, int n_in, void* d_out, int out_size, void* d_ws, size_t ws_size, hipStream_t stream) {
    static int grid = 0;
    if (grid == 0) {
        if (n_in != 17 || in_sizes[0] != T * D || out_size != T * D || ws_size < WS_END) { fprintf(stderr, "kernel_launch: unexpected shapes or workspace (n_in %d, out %d, ws %zu, need %zu); nothing launched\n", n_in, out_size, ws_size, (size_t)WS_END); grid = -1; return; }
        int dev = 0, cus = 0, per_cu = 0;
        if (hipGetDevice(&dev) != hipSuccess || hipDeviceGetAttribute(&cus, hipDeviceAttributeMultiprocessorCount, dev) != hipSuccess) { grid = -1; return; }
        if (hipFuncSetAttribute((const void*)trunk_fwd, hipFuncAttributeMaxDynamicSharedMemorySize, LDS_BYTES) != hipSuccess) { fprintf(stderr, "kernel_launch: hipFuncSetAttribute failed\n"); grid = -1; return; }
        if (hipOccupancyMaxActiveBlocksPerMultiprocessor(&per_cu, (const void*)trunk_fwd, NWAVES * 64, LDS_BYTES) != hipSuccess || per_cu < 1) { fprintf(stderr, "kernel_launch: occupancy query says %d blocks per CU\n", per_cu); (void)hipGetLastError(); grid = -1; return; }
        (void)hipGetLastError();
        grid = cus;
        if (grid != 256) fprintf(stderr, "kernel_launch: %d CUs; the residual GEMM phases need exactly 256 workgroups\n", grid);
    }
    if (grid < 0) return;
    if (hipMemsetAsync((char*)d_ws + WS_CTL, 0, CTL_ZERO_BYTES, stream) != hipSuccess) { fprintf(stderr, "kernel_launch: memset failed\n"); return; }
    Args a{};
    for (int i = 0; i < 17; ++i) a.in[i] = (const float*)d_in[i];
    a.out = (float*)d_out; a.ws = (unsigned char*)d_ws;
    if (MK_N_LAUNCHES == 1) {
        a.ph_lo = 0; a.ph_hi = NPHASE;
        void* kargs[] = {&a};
        const hipError_t le = hipLaunchCooperativeKernel((const void*)trunk_fwd, dim3(grid), dim3(NWAVES * 64), kargs, LDS_BYTES, stream);
        if (le != hipSuccess) fprintf(stderr, "kernel_launch: cooperative launch failed: %s (grid %d)\n", hipGetErrorName(le), grid);
    } else {
        for (int p = 0; p < NPHASE; ++p) { a.ph_lo = p; a.ph_hi = p + 1; hipLaunchKernelGGL(trunk_fwd, dim3(grid), dim3(NWAVES * 64), LDS_BYTES, stream, a); }
    }
}
```

```cpp
#include <hip/hip_runtime.h>
#include <cstdio>
#include <cstdint>

#define GAS __attribute__((address_space(1)))
#define LAS __attribute__((address_space(3)))
typedef unsigned short bf16_t;
typedef short bf16x8 __attribute__((ext_vector_type(8)));
typedef float f32x4 __attribute__((ext_vector_type(4)));
typedef float f32x2 __attribute__((ext_vector_type(2)));
typedef unsigned u32x4 __attribute__((ext_vector_type(4)));
typedef unsigned u32x2 __attribute__((ext_vector_type(2)));

#ifndef MK_N_LAUNCHES
#define MK_N_LAUNCHES 1
#endif
#ifndef PHMASK
#define PHMASK 0x3ff
#endif
#define PHC(c) (((PHMASK) >> (c)) & 1)
#ifndef RES_BF16
#define RES_BF16 1
#endif
#ifndef REP0
#define REP0 1
#endif
#ifndef REP1
#define REP1 1
#endif
#ifndef REP2
#define REP2 1
#endif
#ifndef REP4
#define REP4 1
#endif
#ifndef REP7
#define REP7 1
#endif
#ifndef REP8
#define REP8 1
#endif

constexpr int NBATCH = 8, SEQ = 2048, T = NBATCH * SEQ, D = 1024, INC = 2816, FF = 2816, NEXP = 8, GU = 2 * FF;
constexpr int MAXRB = 135;
constexpr float RMS_EPS = 1e-6f, LN_EPS = 1e-5f;
constexpr float QSCALE = 0.125f * 1.4426950408889634f;
constexpr int NPHASE = 13;

constexpr size_t KiB = 1024, MiB = 1u << 20, HMiB = 1u << 19;
constexpr size_t WS_CTL = 0, CTL_ZERO_BYTES = 1 * MiB;
constexpr size_t WS_RSS = 1 * MiB;
constexpr size_t WS_RINV = WS_RSS + 256 * KiB;
constexpr size_t WS_KPART = WS_RINV + 64 * KiB;
constexpr size_t WS_TOKOF = 2 * MiB;
constexpr size_t WS_GROW = WS_TOKOF + 512 * KiB;
constexpr size_t WS_TSLOT = 3 * MiB;
constexpr size_t WS_WSGU = WS_TSLOT + 128 * KiB;
constexpr size_t WS_WIN = 4 * MiB;
constexpr size_t WS_WOUT = 15 * MiB;
constexpr size_t WS_WGU0 = 19 * MiB;
constexpr size_t WS_WDN0 = 30 * MiB;
constexpr size_t WS_MWDN = 71 * HMiB;
constexpr size_t WS_MWGU = 159 * HMiB;
constexpr size_t WS_XB = 335 * HMiB;
constexpr size_t WS_Z = 399 * HMiB;
constexpr size_t WS_Y = 575 * HMiB;
constexpr size_t WS_H = WS_Z;
constexpr size_t WS_MH = WS_Z;
constexpr size_t WS_YB = WS_MWGU;
constexpr size_t WS_END = WS_MH + (size_t)MAXRB * 256 * FF * 2;
static_assert(WS_WIN + 2 * (size_t)INC * D * 2 <= WS_WOUT && WS_WOUT + 2 * (size_t)D * D * 2 <= WS_WGU0 && WS_WGU0 + (size_t)GU * D * 2 <= WS_WDN0 && WS_WDN0 + (size_t)D * FF * 2 <= WS_MWDN, "ws map 1");
static_assert(WS_MWDN + 8 * (size_t)D * FF * 2 <= WS_MWGU && WS_MWGU + 8 * (size_t)GU * D * 2 <= WS_XB && WS_XB + (size_t)T * D * 2 <= WS_Z && WS_Z + (size_t)T * INC * 2 <= WS_Y, "ws map 2");
static_assert(WS_YB + (size_t)MAXRB * 256 * D * 2 <= WS_XB && WS_TSLOT + (size_t)T * 8 <= WS_WIN && WS_KPART + 64 * 2 * 256 * 4 <= WS_TOKOF, "ws map 3");
constexpr int CW_TMO = 0, CW_CODE = 1;
constexpr int CW_CNT = 64;
constexpr int CW_BAR = 4096;

constexpr int RING_BYTES = 131072;
constexpr int LDSCTL_OFF = RING_BYTES, MISC_OFF = LDSCTL_OFF + 320;
constexpr int LDS_BYTES = 147456;
constexpr int NWAVES = 8;

#define LDS_WAIT() asm volatile("s_waitcnt lgkmcnt(0)" ::: "memory")
#define VM_WAIT() asm volatile("s_waitcnt vmcnt(0)" ::: "memory")
#define RLX_AGENT __ATOMIC_RELAXED, __HIP_MEMORY_SCOPE_AGENT
typedef GAS unsigned gu32;

__device__ __forceinline__ unsigned cvt_pk_bf16(float lo, float hi) { unsigned r; asm volatile("v_cvt_pk_bf16_f32 %0, %1, %2" : "=v"(r) : "v"(lo), "v"(hi)); return r; }
__device__ __forceinline__ float bf_lo(unsigned w) { return __uint_as_float(w << 16); }
__device__ __forceinline__ float bf_hi(unsigned w) { return __uint_as_float(w & 0xffff0000u); }
__device__ __forceinline__ float fast_exp2(float x) { return __builtin_amdgcn_exp2f(x); }
__device__ __forceinline__ float fast_rcp(float x) { return __builtin_amdgcn_rcpf(x); }
__device__ __forceinline__ float silu_f(float g) { return g * fast_rcp(1.f + fast_exp2(-1.4426950408889634f * g)); }
__device__ __forceinline__ float gelu_tanh(float x) { const float u = 0.7978845608028654f * (x + 0.044715f * x * x * x); return x * fast_rcp(1.f + fast_exp2(-2.8853900817779268f * u)); }
__device__ __forceinline__ float wave_sum(float v) {
#pragma unroll
    for (int o = 1; o < 64; o <<= 1) v += __shfl_xor(v, o);
    return v;
}

namespace pg8 {
#define PG8_LAS __attribute__((address_space(3)))
constexpr int BM = 256, BK = 64, HALF = 128, HTB = HALF * BK * 2, STAGE_BYTES = 8 * HTB, NXCD = 8, WGM = 8;
__host__ __device__ __forceinline__ int lds_byte(int r, int c) { const int st = (r >> 4) * 2 + (c >> 5), rr = r & 15, cc = c & 31, ob = rr * 64 + cc * 2; return st * 1024 + (ob ^ (((ob >> 9) & 1) << 5)); }
__host__ __device__ __forceinline__ void stage_rc(int b, int& R, int& C) { const int st = b / 1024, sb = b % 1024, swz = sb ^ (((sb >> 9) & 1) << 5); R = (st >> 1) * 16 + swz / 64; C = (st & 1) * 32 + (swz % 64) / 2; }
__host__ __device__ __forceinline__ int perm32(int rho) { const int n = rho >> 4, i = rho & 15; return 8 * (i >> 2) + 4 * n + (i & 3); }

struct Unit { int pm, pn, e, rb, ce; };

__device__ __forceinline__ bool tile_order(int i, int G, int c, int nM, int nN, int& pm, int& pn) {
    const int nwg = nM * nN; const long L = (long)i * G + c; if (L >= nwg) return false;
    int wgid = (int)L; { const int q = nwg / NXCD, r = nwg % NXCD, xcd = wgid % NXCD, off = wgid / NXCD; wgid = (xcd < r ? xcd * (q + 1) : r * (q + 1) + (xcd - r) * q) + off; }
    const int nig = WGM * nN, gid = wgid / nig, fm = gid * WGM, gsz = (nM - fm) < WGM ? (nM - fm) : WGM;
    pm = fm + ((wgid % nig) % gsz); pn = (wgid % nig) / gsz; return true;
}
struct StaticOrder {
    static constexpr bool GATHER = false;
    int nM, nN, G, c; const char* A; const char* Bt; size_t tstep;
    __device__ __forceinline__ void init(const void* A_, const void* Bt_, int M, int N, int K, int G_, int c_) { nM = M / BM; nN = N / BM; G = G_; c = c_; A = (const char*)A_; Bt = (const char*)Bt_; tstep = (size_t)BM * K * 2; }
    __device__ __forceinline__ bool next(int i, Unit& u) const { u.e = 0; u.rb = 0; u.ce = 0; return tile_order(i, G, c, nM, nN, u.pm, u.pn); }
    __device__ __forceinline__ const char* a_ptr(const Unit& u) const { return A + (size_t)u.pm * tstep; }
    __device__ __forceinline__ const char* b_ptr(const Unit& u) const { return Bt + (size_t)u.pn * tstep; }
    __device__ __forceinline__ void a_voff(const Unit&, const int (&)[2], const int (&)[2], int, unsigned (&)[2][2]) const {}
};
struct MoeOrder {
    int nM, nN, G, c; const char* A; const char* Bt; size_t tstep, estride; const int* tokof;
    int pb[8], cn[8];
    __device__ __forceinline__ void locate(int pm, int& e, int& rb, int& ce) const {
        e = 0; rb = pm; ce = cn[0];
#pragma unroll
        for (int j = 1; j < 8; ++j) if (pm >= pb[j]) { e = j; rb = pm - pb[j]; ce = cn[j]; }
    }
    __device__ __forceinline__ bool next(int i, Unit& u) const { if (!tile_order(i, G, c, nM, nN, u.pm, u.pn)) return false; locate(u.pm, u.e, u.rb, u.ce); return true; }
    __device__ __forceinline__ const char* b_ptr(const Unit& u) const { return Bt + (size_t)u.e * estride + (size_t)u.pn * tstep; }
};
struct MoeGatherOrder : MoeOrder {
    static constexpr bool GATHER = true;
    __device__ __forceinline__ const char* a_ptr(const Unit&) const { return A; }
    __device__ __forceinline__ void a_voff(const Unit& u, const int (&R)[2], const int (&C)[2], int K, unsigned (&v)[2][2]) const {
#pragma unroll
        for (int h = 0; h < 2; ++h)
#pragma unroll
            for (int i = 0; i < 2; ++i) { const int r = u.rb * 256 + h * HALF + R[i]; int tok = 0; if (r < u.ce) tok = tokof[u.e * 16384 + r]; v[h][i] = (unsigned)(tok * K + C[i]) * 2u; }
    }
};
struct MoePlainOrder : MoeOrder {
    static constexpr bool GATHER = false;
    __device__ __forceinline__ const char* a_ptr(const Unit& u) const { return A + (size_t)u.pm * tstep; }
    __device__ __forceinline__ void a_voff(const Unit&, const int (&)[2], const int (&)[2], int, unsigned (&)[2][2]) const {}
};

__device__ __forceinline__ float row_rinv(const float* rss, int r) { const float ss = (rss[r] + rss[T + r]) + (rss[2 * T + r] + rss[3 * T + r]); return __builtin_amdgcn_rsqf(ss * (1.0f / D) + RMS_EPS); }

struct EpiIn {
    static constexpr bool PERM = true, AFTER_DRAIN = false;
    bf16_t* Z; const float* rss; float* kpart;
    __device__ __forceinline__ void operator()(const f32x4 (&acc)[2][2][4][2], const Unit& u, int wr, int wc, int fr, int fq) const {
        const int row0 = u.pm * BM + wr * 64 + fr; const int col0 = u.pn * BM + wc * 32 + 8 * fq;
        const float sc = (u.pn == 0 || u.pn == 8) ? QSCALE : 1.f;
        const bool ksum_tile = (u.pn == 1);
        f32x4 ks[2][2];
#pragma unroll
        for (int bj = 0; bj < 2; ++bj)
#pragma unroll
            for (int n = 0; n < 2; ++n) ks[bj][n] = (f32x4){0.f, 0.f, 0.f, 0.f};
        float riv[2][4];
#pragma unroll
        for (int ai = 0; ai < 2; ++ai)
#pragma unroll
            for (int m = 0; m < 4; ++m) riv[ai][m] = row_rinv(rss, row0 + ai * HALF + m * 16) * sc;
#pragma unroll
        for (int ai = 0; ai < 2; ++ai)
#pragma unroll
            for (int m = 0; m < 4; ++m) { const int r = row0 + ai * HALF + m * 16; const float ri = riv[ai][m]; bf16_t* rowp = Z + (size_t)r * INC + col0;
#pragma unroll
                for (int bj = 0; bj < 2; ++bj) { const f32x4 v0 = acc[ai][bj][m][0] * ri, v1 = acc[ai][bj][m][1] * ri;
                    if (ksum_tile) { ks[bj][0] += v0; ks[bj][1] += v1; }
                    u32x4 w; w.x = cvt_pk_bf16(v0[0], v0[1]); w.y = cvt_pk_bf16(v0[2], v0[3]); w.z = cvt_pk_bf16(v1[0], v1[1]); w.w = cvt_pk_bf16(v1[2], v1[3]);
                    *(u32x4*)(rowp + bj * HALF) = w; } }
        if (ksum_tile) {
#pragma unroll
            for (int bj = 0; bj < 2; ++bj)
#pragma unroll
                for (int n = 0; n < 2; ++n)
#pragma unroll
                    for (int e = 0; e < 4; ++e) { float s = ks[bj][n][e]; s += __shfl_xor(s, 1); s += __shfl_xor(s, 2); s += __shfl_xor(s, 4); s += __shfl_xor(s, 8); ks[bj][n][e] = s; }
            if (fr == 0) { float* kp = kpart + ((size_t)u.pm * 2 + wr) * 256 + wc * 32 + 8 * fq;
#pragma unroll
                for (int bj = 0; bj < 2; ++bj) { *(f32x4*)(kp + bj * HALF) = ks[bj][0]; *(f32x4*)(kp + bj * HALF + 4) = ks[bj][1]; } }
        }
    }
};
struct EpiGU {
    static constexpr bool PERM = true, AFTER_DRAIN = false;
    bf16_t* H; const float* rss;
    __device__ __forceinline__ void operator()(const f32x4 (&acc)[2][2][4][2], const Unit& u, int wr, int wc, int fr, int fq) const {
        const int row0 = u.pm * BM + wr * 64 + fr; const int col0 = u.pn * HALF + wc * 32 + 8 * fq;
        float riv[2][4];
#pragma unroll
        for (int ai = 0; ai < 2; ++ai)
#pragma unroll
            for (int m = 0; m < 4; ++m) riv[ai][m] = row_rinv(rss, row0 + ai * HALF + m * 16);
#pragma unroll
        for (int ai = 0; ai < 2; ++ai)
#pragma unroll
            for (int m = 0; m < 4; ++m) { const int r = row0 + ai * HALF + m * 16; const float ri = riv[ai][m];
                float hv[8];
#pragma unroll
                for (int n = 0; n < 2; ++n)
#pragma unroll
                    for (int e = 0; e < 4; ++e) hv[4 * n + e] = silu_f(acc[ai][0][m][n][e] * ri) * (acc[ai][1][m][n][e] * ri);
                u32x4 w; w.x = cvt_pk_bf16(hv[0], hv[1]); w.y = cvt_pk_bf16(hv[2], hv[3]); w.z = cvt_pk_bf16(hv[4], hv[5]); w.w = cvt_pk_bf16(hv[6], hv[7]);
                *(u32x4*)(H + (size_t)r * FF + col0) = w; }
    }
};
struct EpiGUMoe {
    static constexpr bool PERM = true, AFTER_DRAIN = false;
    bf16_t* H; const float* rinvtok; const int* tokof;
    __device__ __forceinline__ void operator()(const f32x4 (&acc)[2][2][4][2], const Unit& u, int wr, int wc, int fr, int fq) const {
        const int rl0 = wr * 64 + fr; const int col0 = u.pn * HALF + wc * 32 + 8 * fq;
        int tkv[2][4]; float riv[2][4];
#pragma unroll
        for (int ai = 0; ai < 2; ++ai)
#pragma unroll
            for (int m = 0; m < 4; ++m) { const int re = u.rb * 256 + rl0 + ai * HALF + m * 16; int tok = 0; if (re < u.ce) tok = tokof[u.e * 16384 + re]; tkv[ai][m] = tok; }
#pragma unroll
        for (int ai = 0; ai < 2; ++ai)
#pragma unroll
            for (int m = 0; m < 4; ++m) riv[ai][m] = rinvtok[tkv[ai][m]];
#pragma unroll
        for (int ai = 0; ai < 2; ++ai)
#pragma unroll
            for (int m = 0; m < 4; ++m) { const int rl = rl0 + ai * HALF + m * 16; const float ri = riv[ai][m];
                float hv[8];
#pragma unroll
                for (int n = 0; n < 2; ++n)
#pragma unroll
                    for (int e = 0; e < 4; ++e) hv[4 * n + e] = silu_f(acc[ai][0][m][n][e] * ri) * (acc[ai][1][m][n][e] * ri);
                u32x4 w; w.x = cvt_pk_bf16(hv[0], hv[1]); w.y = cvt_pk_bf16(hv[2], hv[3]); w.z = cvt_pk_bf16(hv[4], hv[5]); w.w = cvt_pk_bf16(hv[6], hv[7]);
                *(u32x4*)(H + (size_t)(u.pm * BM + rl) * FF + col0) = w; }
    }
};
struct EpiDnMoe {
    static constexpr bool PERM = true, AFTER_DRAIN = false;
    bf16_t* YB; const float* grow;
    __device__ __forceinline__ void operator()(const f32x4 (&acc)[2][2][4][2], const Unit& u, int wr, int wc, int fr, int fq) const {
        const int rl0 = wr * 64 + fr; const int col0 = u.pn * BM + wc * 32 + 8 * fq;
        float gwv[2][4];
#pragma unroll
        for (int ai = 0; ai < 2; ++ai)
#pragma unroll
            for (int m = 0; m < 4; ++m) { const int re = u.rb * 256 + rl0 + ai * HALF + m * 16; float gw = 0.f; if (re < u.ce) gw = grow[u.e * 16384 + re]; gwv[ai][m] = gw; }
#pragma unroll
        for (int ai = 0; ai < 2; ++ai)
#pragma unroll
            for (int m = 0; m < 4; ++m) { const int rl = rl0 + ai * HALF + m * 16; const float gw = gwv[ai][m];
                bf16_t* rowp = YB + (size_t)(u.pm * BM + rl) * D + col0;
#pragma unroll
                for (int bj = 0; bj < 2; ++bj) { const f32x4 v0 = acc[ai][bj][m][0] * gw, v1 = acc[ai][bj][m][1] * gw;
                    u32x4 w; w.x = cvt_pk_bf16(v0[0], v0[1]); w.y = cvt_pk_bf16(v0[2], v0[3]); w.z = cvt_pk_bf16(v1[0], v1[1]); w.w = cvt_pk_bf16(v1[2], v1[3]);
                    *(u32x4*)(rowp + bj * HALF) = w; } }
    }
};
struct EpiRes {
    static constexpr bool PERM = true, AFTER_DRAIN = true;
    const float* base; float* out; bf16_t* xb; float* rss;
    __device__ __forceinline__ void fused(f32x4 (&acc)[2][2][4][2], const Unit& u, int wr, int wc, int fr, int fq, PG8_LAS unsigned char* lds, int wid, int lane) const {
        PG8_LAS float* P = (PG8_LAS float*)lds;
        const int col0 = u.pn * BM + wc * 32 + 8 * fq;
#pragma unroll
        for (int ai = 0; ai < 2; ++ai)
#pragma unroll
            for (int m = 0; m < 4; ++m) { const int rl = ai * HALF + wr * 64 + m * 16 + fr; const size_t off = (size_t)(u.pm * BM + rl) * D + col0; float ss = 0.f;
#pragma unroll
                for (int bj = 0; bj < 2; ++bj) { const f32x4 b0 = *(const f32x4*)(base + off + bj * HALF), b1 = *(const f32x4*)(base + off + bj * HALF + 4);
                    const f32x4 x0 = b0 + acc[ai][bj][m][0], x1 = b1 + acc[ai][bj][m][1];
                    *(f32x4*)(out + off + bj * HALF) = x0; *(f32x4*)(out + off + bj * HALF + 4) = x1;
                    u32x4 w; w.x = cvt_pk_bf16(x0[0], x0[1]); w.y = cvt_pk_bf16(x0[2], x0[3]); w.z = cvt_pk_bf16(x1[0], x1[1]); w.w = cvt_pk_bf16(x1[2], x1[3]);
                    *(u32x4*)(xb + off + bj * HALF) = w;
                    ss += (x0[0] * x0[0] + x0[1] * x0[1]) + (x0[2] * x0[2] + x0[3] * x0[3]) + (x1[0] * x1[0] + x1[1] * x1[1]) + (x1[2] * x1[2] + x1[3] * x1[3]); }
                ss += __shfl_xor(ss, 16); ss += __shfl_xor(ss, 32);
                if (fq == 0) P[rl * 4 + wc] = ss;
                asm volatile("" ::: "memory"); }
        asm volatile("s_waitcnt lgkmcnt(0)" ::: "memory"); __builtin_amdgcn_s_barrier(); asm volatile("" ::: "memory");
        const int t = wid * 64 + lane;
        if (t < 256) { const f32x4 p = *(const PG8_LAS f32x4*)(P + t * 4); rss[(size_t)u.pn * T + u.pm * BM + t] = (p[0] + p[1]) + (p[2] + p[3]); }
    }
};

struct EpiResB {
    static constexpr bool PERM = true, AFTER_DRAIN = true;
    bf16_t* xb; float* rss;
    __device__ __forceinline__ void fused(f32x4 (&acc)[2][2][4][2], const Unit& u, int wr, int wc, int fr, int fq, PG8_LAS unsigned char* lds, int wid, int lane) const {
        PG8_LAS float* P = (PG8_LAS float*)lds;
        const int col0 = u.pn * BM + wc * 32 + 8 * fq;
        u32x4 bw[2][4][2];
#pragma unroll
        for (int ai = 0; ai < 2; ++ai)
#pragma unroll
            for (int m = 0; m < 4; ++m)
#pragma unroll
                for (int bj = 0; bj < 2; ++bj) bw[ai][m][bj] = *(const u32x4*)(xb + (size_t)(u.pm * BM + ai * HALF + wr * 64 + m * 16 + fr) * D + col0 + bj * HALF);
#pragma unroll
        for (int ai = 0; ai < 2; ++ai)
#pragma unroll
            for (int m = 0; m < 4; ++m) { const int rl = ai * HALF + wr * 64 + m * 16 + fr; const size_t off = (size_t)(u.pm * BM + rl) * D + col0; float ss = 0.f;
#pragma unroll
                for (int bj = 0; bj < 2; ++bj) { const u32x4 b = bw[ai][m][bj];
                    const f32x4 x0 = (f32x4){bf_lo(b.x), bf_hi(b.x), bf_lo(b.y), bf_hi(b.y)} + acc[ai][bj][m][0], x1 = (f32x4){bf_lo(b.z), bf_hi(b.z), bf_lo(b.w), bf_hi(b.w)} + acc[ai][bj][m][1];
                    u32x4 w; w.x = cvt_pk_bf16(x0[0], x0[1]); w.y = cvt_pk_bf16(x0[2], x0[3]); w.z = cvt_pk_bf16(x1[0], x1[1]); w.w = cvt_pk_bf16(x1[2], x1[3]);
                    *(u32x4*)(xb + off + bj * HALF) = w;
                    ss += (x0[0] * x0[0] + x0[1] * x0[1]) + (x0[2] * x0[2] + x0[3] * x0[3]) + (x1[0] * x1[0] + x1[1] * x1[1]) + (x1[2] * x1[2] + x1[3] * x1[3]); }
                ss += __shfl_xor(ss, 16); ss += __shfl_xor(ss, 32);
                if (fq == 0) P[rl * 4 + wc] = ss; }
        asm volatile("s_waitcnt lgkmcnt(0)" ::: "memory"); __builtin_amdgcn_s_barrier(); asm volatile("" ::: "memory");
        const int t = wid * 64 + lane;
        if (t < 256) { const f32x4 p = *(const PG8_LAS f32x4*)(P + t * 4); rss[(size_t)u.pn * T + u.pm * BM + t] = (p[0] + p[1]) + (p[2] + p[3]); }
    }
};

template <class Epi, class Sched, bool ALIGN_EPI, bool SP2>
__device__ __forceinline__ void gemm_phase(PG8_LAS unsigned char* lds, const int K, const Sched& S, const Epi& E) {
    int tid_ = threadIdx.x; asm volatile("" : "+v"(tid_));
    const int tid = tid_, wid = __builtin_amdgcn_readfirstlane(tid >> 6), lane = tid & 63, wr = wid >> 2, wc = wid & 3, fr = lane & 15, fq = lane >> 4;
    const int nt = K / BK;
    unsigned voffA[2], voffB[2]; int stR[2], stC[2];
#pragma unroll
    for (int i = 0; i < 2; ++i) { int R, C; stage_rc(tid * 16 + i * 8192, R, C); const int Rb = Epi::PERM ? ((R & ~31) + perm32(R & 31)) : R;
        voffA[i] = (unsigned)(R * K + C) * 2u; voffB[i] = (unsigned)(Rb * K + C) * 2u; stR[i] = R; stC[i] = C; }
    const size_t kstep = (size_t)(BK * 2);
    const size_t hstep = (size_t)HALF * K * 2;
    const unsigned ldsw = (unsigned)wid * 1024u;
    const int aoff = lds_byte(wr * 64 + fr, fq * 8), boff = lds_byte(wc * 32 + fr, fq * 8);
#define PG8_SA(b, h) (((b) * 2 + (h)) * HTB)
#define PG8_SB(b, h) ((4 + (b) * 2 + (h)) * HTB)
#define PG8_STAGE(bufoff, gbase, voff) do { _Pragma("unroll") for (int _i = 0; _i < 2; ++_i) \
        __builtin_amdgcn_global_load_lds((const unsigned*)((const char*)(gbase) + (voff)[_i]), (PG8_LAS unsigned*)(lds + (bufoff) + ldsw + _i * 8192), 16, 0, 0); } while (0)
#define PG8_STG_A(bufoff, h, kptr, VG) do { if constexpr (Sched::GATHER) { PG8_STAGE(bufoff, kptr, VG[h]); } else { PG8_STAGE(bufoff, (kptr) + (h) * hstep, voffA); } } while (0)
#define PG8_LDA(dst, b, h) do { _Pragma("unroll") for (int m = 0; m < 4; ++m) _Pragma("unroll") for (int k = 0; k < 2; ++k) dst[m][k] = *(const PG8_LAS bf16x8*)(lds + PG8_SA(b, h) + aoff + m * 2048 + k * 1024); } while (0)
#define PG8_LDB(dst, b, h) do { _Pragma("unroll") for (int n = 0; n < 2; ++n) _Pragma("unroll") for (int k = 0; k < 2; ++k) dst[n][k] = *(const PG8_LAS bf16x8*)(lds + PG8_SB(b, h) + boff + n * 2048 + k * 1024); } while (0)
#define PG8_MMA(ai, bj, At, Bt) do { __builtin_amdgcn_s_setprio(1); _Pragma("unroll") for (int m = 0; m < 4; ++m) _Pragma("unroll") for (int n = 0; n < 2; ++n) _Pragma("unroll") for (int k = 0; k < 2; ++k) \
        acc[ai][bj][m][n] = __builtin_amdgcn_mfma_f32_16x16x32_bf16(Bt[n][k], At[m][k], acc[ai][bj][m][n], 0, 0, 0); __builtin_amdgcn_s_setprio(0); } while (0)
#define PG8_WAIT_V(n) asm volatile("s_waitcnt vmcnt(" #n ")" ::: "memory")
#define PG8_WAIT_L(n) asm volatile("s_waitcnt lgkmcnt(" #n ")" ::: "memory")
#define PG8_BAR __builtin_amdgcn_s_barrier()
#define PG8_SCHED __builtin_amdgcn_sched_barrier(0)
    Unit cur, nxt; int ui = 0;
    if (!S.next(0, cur)) return;
    f32x4 acc[2][2][4][2];
#pragma unroll
    for (int a = 0; a < 2; ++a)
#pragma unroll
        for (int b = 0; b < 2; ++b)
#pragma unroll
            for (int m = 0; m < 4; ++m)
#pragma unroll
                for (int n = 0; n < 2; ++n) acc[a][b][m][n] = (f32x4){0.f, 0.f, 0.f, 0.f};
    bf16x8 At[4][2], B0[2][2], B1[2][2];
    unsigned vgc[2][2] = {{0u, 0u}, {0u, 0u}}, vgn[2][2] = {{0u, 0u}, {0u, 0u}};
    const char* cA = S.a_ptr(cur); const char* cB = S.b_ptr(cur);
    if constexpr (Sched::GATHER) { S.a_voff(cur, stR, stC, K, vgc); asm volatile("" : "+v"(vgc[0][0]), "+v"(vgc[0][1]), "+v"(vgc[1][0]), "+v"(vgc[1][1])); }
    if constexpr (SP2) {
        PG8_STAGE(PG8_SB(0, 0), cB, voffB); PG8_STAGE(PG8_SB(0, 1), cB + hstep, voffB); PG8_STG_A(PG8_SA(0, 0), 0, cA, vgc); PG8_STG_A(PG8_SA(0, 1), 1, cA, vgc);
        if (wr == 1) PG8_BAR;
        PG8_WAIT_V(2); PG8_BAR;
        PG8_STAGE(PG8_SB(1, 0), cB + kstep, voffB); PG8_STG_A(PG8_SA(1, 0), 0, cA + kstep, vgc); PG8_STAGE(PG8_SB(1, 1), cB + hstep + kstep, voffB);
        PG8_WAIT_V(6); PG8_BAR;
    } else {
        PG8_STAGE(PG8_SB(0, 0), cB, voffB); PG8_STG_A(PG8_SA(0, 0), 0, cA, vgc); PG8_STAGE(PG8_SB(0, 1), cB + hstep, voffB); PG8_STG_A(PG8_SA(0, 1), 1, cA, vgc);
        if (wr == 1) PG8_BAR;
        PG8_WAIT_V(4); PG8_BAR;
        PG8_STAGE(PG8_SB(1, 0), cB + kstep, voffB); PG8_STG_A(PG8_SA(1, 0), 0, cA + kstep, vgc); PG8_STAGE(PG8_SB(1, 1), cB + hstep + kstep, voffB);
        PG8_WAIT_V(6); PG8_BAR;
    }
    for (;;) {
        const bool has_next = S.next(ui + 1, nxt);
        const char* nA = has_next ? S.a_ptr(nxt) : cA; const char* nB = has_next ? S.b_ptr(nxt) : cB;
        if constexpr (Sched::GATHER) {
            if (has_next) S.a_voff(nxt, stR, stC, K, vgn); else { vgn[0][0] = vgc[0][0]; vgn[0][1] = vgc[0][1]; vgn[1][0] = vgc[1][0]; vgn[1][1] = vgc[1][1]; }
            asm volatile("" : "+v"(vgn[0][0]), "+v"(vgn[0][1]), "+v"(vgn[1][0]), "+v"(vgn[1][1]));
        }
        for (int t = 0; t < nt; t += 2) {
            const bool last = (t == nt - 2);
            const char* a1 = cA + (size_t)(t + 1) * kstep;
            const char* a2 = last ? nA : cA + (size_t)(t + 2) * kstep; const char* b2 = last ? nB : cB + (size_t)(t + 2) * kstep;
            const char* a3 = a2 + kstep; const char* b3 = b2 + kstep;
            unsigned vgx[2][2];
            if constexpr (Sched::GATHER) {
#pragma unroll
                for (int h = 0; h < 2; ++h)
#pragma unroll
                    for (int i = 0; i < 2; ++i) vgx[h][i] = last ? vgn[h][i] : vgc[h][i];
            }
            if constexpr (SP2) {
            PG8_LDB(B0, 0, 0); PG8_LDB(B1, 0, 1); PG8_SCHED; PG8_LDA(At, 0, 0); PG8_STG_A(PG8_SA(1, 1), 1, a1, vgc);
            PG8_WAIT_V(8); PG8_WAIT_L(0); PG8_BAR; PG8_MMA(0, 0, At, B0); PG8_MMA(0, 1, At, B1); PG8_BAR; PG8_SCHED;
            PG8_LDA(At, 0, 1); PG8_STAGE(PG8_SB(0, 0), b2, voffB); PG8_STAGE(PG8_SB(0, 1), b2 + hstep, voffB); PG8_STG_A(PG8_SA(0, 0), 0, a2, vgx);
            PG8_WAIT_V(8); PG8_WAIT_L(0); PG8_BAR; PG8_MMA(1, 0, At, B0); PG8_MMA(1, 1, At, B1); PG8_BAR; PG8_SCHED;
            PG8_LDB(B0, 1, 0); PG8_LDB(B1, 1, 1); PG8_SCHED; PG8_LDA(At, 1, 0); PG8_STG_A(PG8_SA(0, 1), 1, a2, vgx);
            PG8_WAIT_V(8); PG8_WAIT_L(0); PG8_BAR; PG8_MMA(0, 0, At, B0); PG8_MMA(0, 1, At, B1); PG8_BAR; PG8_SCHED;
            PG8_LDA(At, 1, 1); PG8_STAGE(PG8_SB(1, 0), b3, voffB); PG8_STAGE(PG8_SB(1, 1), b3 + hstep, voffB); PG8_STG_A(PG8_SA(1, 0), 0, a3, vgx);
            PG8_WAIT_V(8); PG8_WAIT_L(0); PG8_BAR; PG8_MMA(1, 0, At, B0); PG8_MMA(1, 1, At, B1); PG8_BAR; PG8_SCHED;
            } else {
            PG8_LDB(B0, 0, 0); PG8_SCHED; PG8_LDA(At, 0, 0); PG8_STG_A(PG8_SA(1, 1), 1, a1, vgc);
            PG8_WAIT_L(8); PG8_BAR; PG8_WAIT_L(0); PG8_MMA(0, 0, At, B0); PG8_BAR; PG8_SCHED;
            PG8_LDB(B1, 0, 1); PG8_STAGE(PG8_SB(0, 0), b2, voffB);
            PG8_BAR; PG8_WAIT_L(0); PG8_MMA(0, 1, At, B1); PG8_BAR;
            PG8_LDA(At, 0, 1); PG8_STG_A(PG8_SA(0, 0), 0, a2, vgx);
            PG8_BAR; PG8_WAIT_L(0); PG8_MMA(1, 0, At, B0); PG8_BAR; PG8_SCHED;
            PG8_STAGE(PG8_SB(0, 1), b2 + hstep, voffB);
            PG8_WAIT_V(6); PG8_BAR; PG8_MMA(1, 1, At, B1); PG8_BAR;
            PG8_LDB(B0, 1, 0); PG8_SCHED; PG8_LDA(At, 1, 0); PG8_STG_A(PG8_SA(0, 1), 1, a2, vgx);
            PG8_WAIT_L(8); PG8_BAR; PG8_WAIT_L(0); PG8_MMA(0, 0, At, B0); PG8_BAR; PG8_SCHED;
            PG8_LDB(B1, 1, 1); PG8_STAGE(PG8_SB(1, 0), b3, voffB);
            PG8_BAR; PG8_WAIT_L(0); PG8_MMA(0, 1, At, B1); PG8_BAR;
            PG8_LDA(At, 1, 1); PG8_STG_A(PG8_SA(1, 0), 0, a3, vgx);
            PG8_BAR; PG8_WAIT_L(0); PG8_MMA(1, 0, At, B0); PG8_BAR; PG8_SCHED;
            PG8_STAGE(PG8_SB(1, 1), b3 + hstep, voffB);
            PG8_WAIT_V(6); PG8_BAR; PG8_MMA(1, 1, At, B1); PG8_BAR;
            }
        }
        if constexpr (ALIGN_EPI) { if (wr == 0) PG8_BAR; }
        if constexpr (!Epi::AFTER_DRAIN) { E(acc, cur, wr, wc, fr, fq); }
        if (!has_next) break;
#pragma unroll
        for (int a = 0; a < 2; ++a)
#pragma unroll
            for (int b = 0; b < 2; ++b)
#pragma unroll
                for (int m = 0; m < 4; ++m)
#pragma unroll
                    for (int n = 0; n < 2; ++n) acc[a][b][m][n] = (f32x4){0.f, 0.f, 0.f, 0.f};
        cur = nxt; cA = nA; cB = nB; ++ui;
        if constexpr (Sched::GATHER) { vgc[0][0] = vgn[0][0]; vgc[0][1] = vgn[0][1]; vgc[1][0] = vgn[1][0]; vgc[1][1] = vgn[1][1]; }
        if constexpr (ALIGN_EPI) { if (wr == 1) PG8_BAR; }
    }
    PG8_WAIT_V(0);
    if constexpr (!ALIGN_EPI) { if (wr == 0) PG8_BAR; }
    PG8_BAR;
    if constexpr (Epi::AFTER_DRAIN) { E.fused(acc, cur, wr, wc, fr, fq, lds, wid, lane); }
#undef PG8_SA
#undef PG8_SB
#undef PG8_STAGE
#undef PG8_STG_A
#undef PG8_LDA
#undef PG8_LDB
#undef PG8_MMA
#undef PG8_WAIT_V
#undef PG8_WAIT_L
#undef PG8_BAR
#undef PG8_SCHED
}
}

#define XB_TMO      128
#define XB_XCNT(j)  (256  + 64 * (j))
#define XB_XSUB(j)  (1280 + 64 * (j))
#define XB_XGEN(j)  (2304 + 64 * (j))
#define XB_TOP      3328
#define XB_TOPGEN   3392
#define XCD_BAR_WORDS 3456
#define XB_SPIN_CAP (1u << 18)
__device__ __forceinline__ unsigned xb_ld(unsigned* p)              { return __hip_atomic_load(p, __ATOMIC_RELAXED, __HIP_MEMORY_SCOPE_AGENT); }
__device__ __forceinline__ unsigned xb_add(unsigned* p, unsigned v) { return __hip_atomic_fetch_add(p, v, __ATOMIC_RELAXED, __HIP_MEMORY_SCOPE_AGENT); }
__device__ __forceinline__ unsigned xb_xcc_id() { return (unsigned)__builtin_amdgcn_s_getreg((3 << 11) | 20) & 0xFu; }
#define XB_SPIN(cond, bar) do { unsigned _sp = 0; while (cond) { __builtin_amdgcn_s_sleep(1); \
    if ((++_sp & 255u) == 0u) { if (xb_ld(&(bar)[XB_TMO])) break; if (_sp > XB_SPIN_CAP) { atomicAdd(&(bar)[XB_TMO], 1u); break; } } } } while (0)
struct XcdBarrier { unsigned* bar; unsigned x; volatile LAS unsigned* st; };
__device__ __forceinline__ XcdBarrier xcd_barrier_post(unsigned* bar, volatile LAS unsigned* st) {
    XcdBarrier b; b.bar = bar; b.x = xb_xcc_id(); b.st = st;
    if (threadIdx.x == 0) (void)xb_add(&bar[XB_XCNT(b.x)], 1u);
    return b;
}
__device__ __forceinline__ void xcd_barrier_complete(unsigned* bar, unsigned x, unsigned& nloc, unsigned& nx) {
    const unsigned G = gridDim.x * gridDim.y * gridDim.z;
    unsigned sum, cnt, mine, sp = 0u;
    for (;;) {
        sum = 0u; cnt = 0u; mine = 0u;
#pragma unroll
        for (unsigned j = 0; j < 16; ++j) { const unsigned c = xb_ld(&bar[XB_XCNT(j)]); sum += c; cnt += (c > 0u) ? 1u : 0u; mine = (j == x) ? c : mine; }
        if (sum == G) break;
        __builtin_amdgcn_s_sleep(1);
        if ((++sp & 255u) == 0u) { if (xb_ld(&bar[XB_TMO])) break; if (sp > XB_SPIN_CAP) { atomicAdd(&bar[XB_TMO], 1u); break; } }
    }
    nloc = mine > 0u ? mine : 1u; nx = cnt > 0u ? cnt : 1u;
}
__device__ __forceinline__ void xcd_barrier(const XcdBarrier& b) {
    asm volatile("s_waitcnt vmcnt(0)" ::: "memory");
    __syncthreads();
    if (threadIdx.x == 0) {
        unsigned* bar = b.bar;
        __builtin_amdgcn_s_waitcnt(0);
        unsigned nloc = b.st[0], nx = b.st[1];
        if (nloc == 0u) { xcd_barrier_complete(bar, b.x, nloc, nx); b.st[0] = nloc; b.st[1] = nx; }
        const unsigned old = xb_add(&bar[XB_XSUB(b.x)], 1u);
        const unsigned gen = old / nloc;
        if (old + 1u == (gen + 1u) * nloc) {
            __builtin_amdgcn_fence(__ATOMIC_RELEASE, "agent");
            asm volatile("s_waitcnt vmcnt(0)" ::: "memory");
            const unsigned og = xb_add(&bar[XB_TOP], 1u);
            const unsigned tg = og / nx;
            if (og + 1u == (tg + 1u) * nx) xb_add(&bar[XB_TOPGEN], 1u);
            else XB_SPIN(xb_ld(&bar[XB_TOPGEN]) == tg, bar);
            __builtin_amdgcn_fence(__ATOMIC_ACQUIRE, "agent");
            xb_add(&bar[XB_XGEN(b.x)], 1u);
            asm volatile("s_waitcnt vmcnt(0)" ::: "memory");
        } else {
            XB_SPIN(xb_ld(&bar[XB_XGEN(b.x)]) == gen, bar);
            __builtin_amdgcn_fence(__ATOMIC_ACQUIRE, "agent");
            asm volatile("s_waitcnt vmcnt(0)" ::: "memory");
        }
    }
    __syncthreads();
}

namespace attn_body {
using bf16=unsigned short;
using bf16x8=__attribute__((ext_vector_type(8)))short;
using s16x4=__attribute__((ext_vector_type(4)))short;
using f32x16=__attribute__((ext_vector_type(16)))float;
using u32x4=__attribute__((ext_vector_type(4)))unsigned;
using f32x4v=__attribute__((ext_vector_type(4)))float;
constexpr int SEQ=2048,D=64,PITCH=2816,OPITCH=1024;
constexpr int NW=8,QBLK=32,QB=QBLK*NW,KVBLK=64;
__device__ __forceinline__ int crow(int r,int hi){return (r&3)+8*(r>>2)+4*hi;}
#define SBAR() __builtin_amdgcn_sched_barrier(0)
__device__ __forceinline__ void cmask(f32x16&p0,f32x16&p1,int jb,int qrel,int hi){
  const float NEG=-INFINITY; int kb=64*jb+4*hi;
  #pragma unroll
  for(int r=0;r<16;++r){int kv=kb+(r&3)+8*(r>>2); if(kv>qrel)p0[r]=NEG; if(kv+32>qrel)p1[r]=NEG;}
}
constexpr int NSLOT=3, SLOTB=8192;
constexpr int LDS_K=0, LDS_V=NSLOT*SLOTB, LDS_WS=2*NSLOT*SLOTB, LDS_OST=LDS_WS+NW*64*4, LDS_KSUM=LDS_OST+NW*4096, LDS_LUT=LDS_KSUM+2048, LUT_N=2304, LDS_BYTES=LDS_LUT+LUT_N*16;
__device__ __forceinline__ void glds16(const void*gsrc,unsigned lds_dst){unsigned keep;
  asm volatile("s_mov_b32 %0, m0\n\ts_mov_b32 m0, %2\n\ts_nop 0\n\tglobal_load_lds_dwordx4 %1, off\n\ts_mov_b32 m0, %0":"=&s"(keep):"v"(gsrc),"s"(lds_dst):"memory");}
__device__ __forceinline__ float max3f(float a,float b,float c){float r;asm("v_max3_f32 %0, %1, %2, %3":"=v"(r):"v"(a),"v"(b),"v"(c));return r;}
__device__ __forceinline__ float max2f(float a,float b){float r;asm("v_max_f32_e32 %0, %1, %2":"=v"(r):"v"(a),"v"(b));return r;}
__device__ __forceinline__ float fadd_s(float a,float b){float r;asm("v_add_f32_e32 %0, %1, %2":"=v"(r):"v"(a),"v"(b));return r;}
__device__ __forceinline__ float fsub_s(float a,float b){float r;asm("v_sub_f32_e32 %0, %1, %2":"=v"(r):"v"(a),"v"(b));return r;}
typedef float f32x2_t __attribute__((ext_vector_type(2))); typedef __bf16 bf16x2_t __attribute__((ext_vector_type(2)));
__device__ __forceinline__ unsigned cvtpk_s(float lo,float hi){f32x2_t v={lo,hi};bf16x2_t b=__builtin_convertvector(v,bf16x2_t);return __builtin_bit_cast(unsigned,b);}
#define WAIT_BAR(N) asm volatile("s_waitcnt vmcnt(" #N ") lgkmcnt(0)\n\ts_barrier":::"memory")

__device__ __forceinline__ void qkt(f32x16&p0,f32x16&p1,const char*Kslot,const bf16x8*qr,int r32,int hi){
  const char*kb=Kslot+hi*1024+r32*16;
  #pragma unroll
  for(int d0=0;d0<4;++d0){
    const bf16x8 b0=*reinterpret_cast<const bf16x8*>(kb+d0*2048);
    const bf16x8 b1=*reinterpret_cast<const bf16x8*>(kb+d0*2048+512);
    p0=__builtin_amdgcn_mfma_f32_32x32x16_bf16(b0,qr[d0],p0,0,0,0);p1=__builtin_amdgcn_mfma_f32_32x32x16_bf16(b1,qr[d0],p1,0,0,0);}
}
typedef __attribute__((address_space(3))) const char* lds_cptr;
typedef short v4i16_t __attribute__((ext_vector_type(4)));
__device__ __forceinline__ void kload8(bf16x8*kf,lds_cptr kp){
  kf[0]=*(const __attribute__((address_space(3))) bf16x8*)(kp);      kf[1]=*(const __attribute__((address_space(3))) bf16x8*)(kp+512);
  kf[2]=*(const __attribute__((address_space(3))) bf16x8*)(kp+2048); kf[3]=*(const __attribute__((address_space(3))) bf16x8*)(kp+2560);
  kf[4]=*(const __attribute__((address_space(3))) bf16x8*)(kp+4096); kf[5]=*(const __attribute__((address_space(3))) bf16x8*)(kp+4608);
  kf[6]=*(const __attribute__((address_space(3))) bf16x8*)(kp+6144); kf[7]=*(const __attribute__((address_space(3))) bf16x8*)(kp+6656);
}
__device__ __forceinline__ void kload2(bf16x8*kf,lds_cptr kp,int j){ kf[2*j]=*(const __attribute__((address_space(3))) bf16x8*)(kp+j*2048); kf[2*j+1]=*(const __attribute__((address_space(3))) bf16x8*)(kp+j*2048+512); }
__device__ __forceinline__ s16x4 vtr(lds_cptr p){ return __builtin_bit_cast(s16x4,__builtin_amdgcn_ds_read_tr16_b64_v4i16((__attribute__((address_space(3))) v4i16_t*)p)); }
__device__ __forceinline__ float rowmax(const f32x16&p0,const f32x16&p1){
  float a=max3f(p0[0],p0[1],p1[0]),b=max3f(p0[2],p0[3],p1[1]);a=max3f(a,p1[2],p1[3]);
  #pragma unroll
  for(int r=4;r<16;r+=4){a=max3f(a,p0[r],p0[r+1]);b=max3f(b,p0[r+2],p0[r+3]);a=max3f(a,p1[r],p1[r+1]);b=max3f(b,p1[r+2],p1[r+3]);}
  const float m=max2f(a,b);
  auto rr=__builtin_amdgcn_permlane32_swap(__float_as_uint(m),__float_as_uint(m),false,false);
  return max2f(__uint_as_float(rr[0]),__uint_as_float(rr[1]));
}
__device__ __forceinline__ void pv(f32x16*o,int vb,bf16x8 pa0,bf16x8 pa1,bf16x8 pa2,bf16x8 pa3){
  #pragma unroll
  for(int d0=0;d0<2;++d0){s16x4 lo[4],hi[4];
    #pragma unroll
    for(int ks=0;ks<4;++ks){
      asm volatile("ds_read_b64_tr_b16 %0,%1 offset:%c2":"=&v"(lo[ks]):"v"(vb),"i"(d0*4096+ks*1024):"memory");
      asm volatile("ds_read_b64_tr_b16 %0,%1 offset:%c2":"=&v"(hi[ks]):"v"(vb),"i"(d0*4096+ks*1024+512):"memory");}
    asm volatile("s_waitcnt lgkmcnt(0)":::"memory");SBAR();
    #define PK(k) (bf16x8){lo[k][0],lo[k][1],lo[k][2],lo[k][3],hi[k][0],hi[k][1],hi[k][2],hi[k][3]}
    o[d0]=__builtin_amdgcn_mfma_f32_32x32x16_bf16(pa0,PK(0),o[d0],0,0,0);
    o[d0]=__builtin_amdgcn_mfma_f32_32x32x16_bf16(pa1,PK(1),o[d0],0,0,0);
    o[d0]=__builtin_amdgcn_mfma_f32_32x32x16_bf16(pa2,PK(2),o[d0],0,0,0);
    o[d0]=__builtin_amdgcn_mfma_f32_32x32x16_bf16(pa3,PK(3),o[d0],0,0,0);
    #undef PK
  }
}
__device__ __forceinline__ float dil_bias(int d){
  if(d<0)return -INFINITY;
  const int c=(d<=128?1:0)+(((d&3)==0&&d<=512)?1:0)+(((d&15)==0)?1:0);
  return c==0?-INFINITY:(c==1?0.f:(c==2?1.f:1.5849625007211562f));
}
__device__ __forceinline__ void build_dil_lut(char*shm){
  float*lut=(float*)(shm+LDS_LUT);
  int tid_=threadIdx.x; asm volatile("":"+v"(tid_));
  for(int x=tid_;x<LUT_N;x+=512){ const int d=x-256; *(f32x4v*)(lut+4*x)=(f32x4v){dil_bias(d),dil_bias(d-1),dil_bias(d-2),dil_bias(d-3)}; }
  asm volatile("s_waitcnt lgkmcnt(0)\n\ts_barrier":::"memory");
}
__device__ __forceinline__ void stage_ksum(char*shm,const float*kpart,int b,int h){
  float*ksm=(float*)(shm+LDS_KSUM); int tid_=threadIdx.x; asm volatile("":"+v"(tid_)); const int tid=tid_,j=tid>>6,d=tid&63;
  const float*kp=kpart+((size_t)(b*8+j)*2)*256+h*64+d; ksm[tid]=kp[0]+kp[256];
  asm volatile("s_waitcnt vmcnt(0) lgkmcnt(0)\n\ts_barrier":::"memory");
}

template<int MODE,int THRL> __device__ __forceinline__ void attn_unit(int b,int h,int qb,const bf16*Q,const bf16*__restrict__ K,const bf16*__restrict__ V,bf16*O,char*shm){
  int tid_=threadIdx.x; asm volatile("":"+v"(tid_));
  const int tid=tid_,lane=tid&63,r32=lane&31,hi=lane>>5; const int wid=__builtin_amdgcn_readfirstlane(tid>>6);
  const long rowbase=(long)b*SEQ; const int q0=qb*QB;
  const bf16*Qw=Q+(rowbase+q0+wid*QBLK)*PITCH+h*D;
  const bf16*Kh=K+rowbase*PITCH+h*D,*Vh=V+rowbase*PITCH+h*D;
  const unsigned lds0=(unsigned)(uintptr_t)shm;
  float*wsf=(float*)(shm+LDS_WS)+wid*64;
  const bf16*ksrc=Kh+(long)lane*PITCH+wid*8;
  const bf16*vsrc=Vh+(long)(16*(wid&3)+(lane>>2))*PITCH+(wid>>2)*32+(lane&3)*8;
  const unsigned kdst=lds0+LDS_K+wid*1024, vdst=lds0+LDS_V+wid*1024;
  const int NT=(q0+QB)/KVBLK;
  #define TILE(t) (((t)<4)?(NT-4+(t)):((t)-4))
  #define DMA_K(t,slot) glds16(ksrc+(long)TILE(t)*KVBLK*PITCH,(unsigned)__builtin_amdgcn_readfirstlane(kdst+(slot)))
  #define DMA_V(t,slot) glds16(vsrc+(long)TILE(t)*KVBLK*PITCH,(unsigned)__builtin_amdgcn_readfirstlane(vdst+(slot)))
  const int vb0=(int)(lds0+LDS_V)+((lane>>4)&1)*32+(lane&3)*8+(4*hi+((lane&15)>>2))*64;
  const char*Kbase=shm+LDS_K; bf16x8 kf[8];
  const lds_cptr shm3=(lds_cptr)shm; const lds_cptr kp0=shm3+LDS_K+hi*1024+r32*16; const lds_cptr vp0=shm3+LDS_V+((lane>>4)&1)*32+(lane&3)*8+(4*hi+((lane&15)>>2))*64;
  DMA_K(0,0);DMA_V(0,0);DMA_K(1,SLOTB);
  bf16x8 qr[4];
  #pragma unroll
  for(int d0=0;d0<4;++d0)qr[d0]=*reinterpret_cast<const bf16x8*>(&Qw[(long)r32*PITCH+d0*16+hi*8]);
  const int qrel=wid*QBLK+r32;
  unsigned selm=0u;
  if constexpr(MODE==0){
    if(qb>0){
      const float*ksm=(const float*)(shm+LDS_KSUM);
      float b0=-INFINITY,b1=-INFINITY,b2=-INFINITY;int i0=-1,i1=-1,i2=-1;
      #pragma unroll 1
      for(int j=0;j<qb;++j){
        const float*kj=ksm+j*64+8*hi; float a0=0.f,a1=0.f;
        #pragma unroll
        for(int d0=0;d0<4;++d0){ const f32x4v x0=*(const f32x4v*)(kj+16*d0),x1=*(const f32x4v*)(kj+16*d0+4);
          #define QF(jj) __uint_as_float(((unsigned)(unsigned short)qr[d0][jj])<<16)
          a0+=QF(0)*x0[0]+QF(1)*x0[1]+QF(2)*x0[2]+QF(3)*x0[3]; a1+=QF(4)*x1[0]+QF(5)*x1[1]+QF(6)*x1[2]+QF(7)*x1[3];
          #undef QF
          asm volatile("":"+v"(a0),"+v"(a1)); }
        float a=a0+a1; { auto rr=__builtin_amdgcn_permlane32_swap(__float_as_uint(a),__float_as_uint(a),false,false); a=__uint_as_float(rr[0])+__uint_as_float(rr[1]); }
        if(a>b0){b2=b1;i2=i1;b1=b0;i1=i0;b0=a;i0=j;} else if(a>b1){b2=b1;i2=i1;b1=a;i1=j;} else if(a>b2){b2=a;i2=j;}
      }
      if(i0>=0)selm|=1u<<i0; if(i1>=0)selm|=1u<<i1; if(i2>=0)selm|=1u<<i2;
    }
  }
  [[maybe_unused]] const lds_cptr lutb=shm3+LDS_LUT+16*(qrel-4*hi+256-56);
  float mhat=0.f,l_reg=0.f;f32x16 o[2];o[0]=f32x16{};o[1]=f32x16{};
  #define KREL(t) (((t)<4)?(64*(t)):(64*((t)-4)-q0))
  #define INIT(P0,P1,t) do{ \
    if constexpr(MODE==0){ float iv_=-mhat; if((t)>=4){ const bool on_=(selm>>(((t)>=4?(t)-4:0)>>2))&1u; iv_=on_?iv_:-INFINITY; } \
      _Pragma("unroll") for(int r=0;r<16;++r){ P0[r]=iv_; P1[r]=iv_; } } \
    else { const lds_cptr lp_=lutb-16*KREL(t); const float nm_=-mhat; \
      _Pragma("unroll") for(int g_=0;g_<4;++g_){ const f32x4v u0_=*(const __attribute__((address_space(3))) f32x4v*)(lp_+16*(56-8*g_)), u1_=*(const __attribute__((address_space(3))) f32x4v*)(lp_+16*(24-8*g_)); \
        P0[4*g_]=u0_[0]+nm_;P0[4*g_+1]=u0_[1]+nm_;P0[4*g_+2]=u0_[2]+nm_;P0[4*g_+3]=u0_[3]+nm_; P1[4*g_]=u1_[0]+nm_;P1[4*g_+1]=u1_[1]+nm_;P1[4*g_+2]=u1_[2]+nm_;P1[4*g_+3]=u1_[3]+nm_; } } \
    asm volatile("":"+v"(P0),"+v"(P1)); }while(0)
  #define FIXUP(P0,P1,t) do{ if constexpr(MODE==0){ if((t)<4){ cmask(P0,P1,(t),qrel,hi); } } }while(0)
  bool resc=false;
  #define START(P0,P1) do{ const float rm=rowmax(P0,P1); resc=false; \
    { const float dl=rm; mhat=fadd_s(mhat,dl); \
      _Pragma("unroll") for(int r=0;r<16;++r){P0[r]=fsub_s(P0[r],dl);P1[r]=fsub_s(P1[r],dl);} } \
    _Pragma("unroll") for(int r=0;r<16;++r)P0[r]=__builtin_amdgcn_exp2f(P0[r]); }while(0)
  #define RESC() do{ if(resc){ asm volatile("s_waitcnt lgkmcnt(0)":::"memory"); \
      _Pragma("unroll") for(int d_=0;d_<2;++d_) _Pragma("unroll") for(int r=0;r<16;++r)o[d_][r]*=wsf[crow(r,hi)]; } }while(0)
  f32x16 pA0,pA1,pB0,pB1;
  int sl_prev=0,sl_cur=0,sl_next=SLOTB;
  #define ROT() do{sl_prev=sl_cur;sl_cur=sl_next;sl_next=(sl_next==(NSLOT-1)*SLOTB)?0:sl_next+SLOTB;}while(0)
  DMA_K(2,2*SLOTB);
  WAIT_BAR(3);
  INIT(pA0,pA1,0); qkt(pA0,pA1,Kbase,qr,r32,hi);asm volatile("s_nop 15\n\ts_nop 7":"+v"(pA0),"+v"(pA1));FIXUP(pA0,pA1,0);
  START(pA0,pA1);
  _Pragma("unroll") for(int r=0;r<16;++r)pA1[r]=__builtin_amdgcn_exp2f(pA1[r]);
  WAIT_BAR(0);
  DMA_K(3,0);DMA_V(1,SLOTB);
  ROT();
  kload8(kf,kp0+sl_cur);
  WAIT_BAR(2);
  s16x4 vlo[8],vhi[8]; u32x4 pw0,pw1,pw2,pw3;
  #define PKW(P,B) cvtpk_s(P[B],P[B+1])
  #define PAF(k) __builtin_bit_cast(bf16x8,pw##k)
  #define VFR(i) (bf16x8){vlo[i][0],vlo[i][1],vlo[i][2],vlo[i][3],vhi[i][0],vhi[i][1],vhi[i][2],vhi[i][3]}
  #define PIN(x) asm volatile("":"+v"(x))
  #define MX3(a,b,c) __builtin_fmaxf(__builtin_fmaxf((a),(b)),(c))
  #define GAPA(MF,A0,A1,A2,A3,W0,W1,PW) do{ MF; sacc+=A0; sacc+=A1; sacc+=A2; sacc+=A3; PIN(sacc); W0; W1; PIN(PW); SBAR(); }while(0)
  #define EX(v) __builtin_amdgcn_exp2f(v)
  #define GAPB(MF,X,B) do{ MF; X[B]=EX(X[B]); X[B+1]=EX(X[B+1]); X[B+2]=EX(X[B+2]); X[B+3]=EX(X[B+3]); PIN(X); SBAR(); }while(0)
  #define VRD(i) do{ vlo[i]=vtr(vp_+(((i)>>2)*4096+((i)&3)*1024)); vhi[i]=vtr(vp_+(((i)>>2)*4096+((i)&3)*1024+512)); }while(0)
  #define KRD(G,j) do{ if(G){ kload2(kf,kp0+sl_next,j); SBAR(); } }while(0)
  #define STEP(C0,C1,P0,P1,t,GK,GV,GL) do{ SBAR(); INIT(C0,C1,t); SBAR(); \
    const lds_cptr vp_=vp0+sl_prev; \
    VRD(0); SBAR(); float sacc=(P0[0]+P0[1]); \
    GAPA(C0=__builtin_amdgcn_mfma_f32_32x32x16_bf16(kf[0],qr[0],C0,0,0,0), P0[2],P0[3],P0[4],P0[5],     pw0[0]=PKW(P0,0), pw0[1]=PKW(P0,2), pw0); \
    VRD(4); SBAR(); GAPA(C1=__builtin_amdgcn_mfma_f32_32x32x16_bf16(kf[1],qr[0],C1,0,0,0), P0[6],P0[7],P0[8],P0[9],     pw0[2]=PKW(P0,4), pw0[3]=PKW(P0,6), pw0); \
    VRD(1); SBAR(); GAPA(C0=__builtin_amdgcn_mfma_f32_32x32x16_bf16(kf[2],qr[1],C0,0,0,0),   P0[10],P0[11],P0[12],P0[13], pw1[0]=PKW(P0,8), pw1[1]=PKW(P0,10), pw1); \
    VRD(5); SBAR(); GAPA(C1=__builtin_amdgcn_mfma_f32_32x32x16_bf16(kf[3],qr[1],C1,0,0,0),   P0[14],P0[15],P1[0],P1[1],   pw1[2]=PKW(P0,12),pw1[3]=PKW(P0,14), pw1); \
    VRD(2); SBAR(); GAPA(C0=__builtin_amdgcn_mfma_f32_32x32x16_bf16(kf[4],qr[2],C0,0,0,0),   P1[2],P1[3],P1[4],P1[5],     pw2[0]=PKW(P1,0), pw2[1]=PKW(P1,2), pw2); \
    VRD(6); SBAR(); GAPA(C1=__builtin_amdgcn_mfma_f32_32x32x16_bf16(kf[5],qr[2],C1,0,0,0),   P1[6],P1[7],P1[8],P1[9],     pw2[2]=PKW(P1,4), pw2[3]=PKW(P1,6), pw2); \
    VRD(3); SBAR(); GAPA(C0=__builtin_amdgcn_mfma_f32_32x32x16_bf16(kf[6],qr[3],C0,0,0,0),   P1[10],P1[11],P1[12],P1[13], pw3[0]=PKW(P1,8), pw3[1]=PKW(P1,10), pw3); \
    VRD(7); SBAR(); GAPA(C1=__builtin_amdgcn_mfma_f32_32x32x16_bf16(kf[7],qr[3],C1,0,0,0),   P1[14],P1[15],0.f,0.f,       pw3[2]=PKW(P1,12),pw3[3]=PKW(P1,14), pw3); \
    l_reg+=sacc; \
    if(GK){DMA_K((t)+3,sl_cur);} if(GV){DMA_V((t)+1,sl_next);} \
    FIXUP(C0,C1,t); \
    { float a=MX3(C0[0],C0[1],C1[0]),b=MX3(C0[2],C0[3],C1[1]); a=MX3(a,C1[2],C1[3]); \
      _Pragma("unroll") for(int r=4;r<16;r+=4){a=MX3(a,C0[r],C0[r+1]);b=MX3(b,C0[r+2],C0[r+3]);a=MX3(a,C1[r],C1[r+1]);b=MX3(b,C1[r+2],C1[r+3]);} \
      float rm=__builtin_fmaxf(a,b); { auto rr=__builtin_amdgcn_permlane32_swap(__float_as_uint(rm),__float_as_uint(rm),false,false); rm=__builtin_fmaxf(__uint_as_float(rr[0]),__uint_as_float(rr[1])); } \
      resc=false; \
      if(__builtin_expect(__any(rm>(float)THRL),0)){ const float dl=__builtin_fmaxf(rm,0.f); mhat+=dl; \
        _Pragma("unroll") for(int r=0;r<16;++r){C0[r]-=dl;C1[r]-=dl;} \
        const float f=__builtin_amdgcn_exp2f(-dl); l_reg*=f; if(hi==0)wsf[r32]=f; resc=true; } } \
    SBAR(); \
    GAPB(o[0]=__builtin_amdgcn_mfma_f32_32x32x16_bf16(PAF(0),VFR(0),o[0],0,0,0), C0,0); \
    GAPB(o[1]=__builtin_amdgcn_mfma_f32_32x32x16_bf16(PAF(0),VFR(4),o[1],0,0,0), C0,4); \
    KRD(GL,0); GAPB(o[0]=__builtin_amdgcn_mfma_f32_32x32x16_bf16(PAF(1),VFR(1),o[0],0,0,0), C0,8); \
    KRD(GL,1); GAPB(o[1]=__builtin_amdgcn_mfma_f32_32x32x16_bf16(PAF(1),VFR(5),o[1],0,0,0), C0,12); \
    KRD(GL,2); GAPB(o[0]=__builtin_amdgcn_mfma_f32_32x32x16_bf16(PAF(2),VFR(2),o[0],0,0,0), C1,0); \
    KRD(GL,3); GAPB(o[1]=__builtin_amdgcn_mfma_f32_32x32x16_bf16(PAF(2),VFR(6),o[1],0,0,0), C1,4); \
    GAPB(o[0]=__builtin_amdgcn_mfma_f32_32x32x16_bf16(PAF(3),VFR(3),o[0],0,0,0), C1,8); \
    GAPB(o[1]=__builtin_amdgcn_mfma_f32_32x32x16_bf16(PAF(3),VFR(7),o[1],0,0,0), C1,12); \
    }while(0)
  #define ENDW(tt) do{ if((tt)+3<NT){WAIT_BAR(2);} else if((tt)+2<NT){WAIT_BAR(1);} else {WAIT_BAR(0);} }while(0)
  int t=1;
  for(;t+1<NT;t+=2){
    STEP(pB0,pB1,pA0,pA1,t,(t+3<NT),(t+1<NT),(t+1<NT));       ENDW(t);   RESC(); ROT();
    STEP(pA0,pA1,pB0,pB1,t+1,(t+4<NT),(t+2<NT),(t+2<NT));     ENDW(t+1); RESC(); ROT();
  }
  STEP(pB0,pB1,pA0,pA1,NT-1,false,false,false); RESC();
  { float sacc=pB0[0]+pB0[1]; _Pragma("unroll") for(int r=2;r<16;++r)sacc+=pB0[r]; _Pragma("unroll") for(int r=0;r<16;++r)sacc+=pB1[r]; l_reg+=sacc;
    pw0=(u32x4){PKW(pB0,0),PKW(pB0,2),PKW(pB0,4),PKW(pB0,6)};pw1=(u32x4){PKW(pB0,8),PKW(pB0,10),PKW(pB0,12),PKW(pB0,14)};pw2=(u32x4){PKW(pB1,0),PKW(pB1,2),PKW(pB1,4),PKW(pB1,6)};pw3=(u32x4){PKW(pB1,8),PKW(pB1,10),PKW(pB1,12),PKW(pB1,14)};
    SBAR(); pv(o,vb0+sl_cur,PAF(0),PAF(1),PAF(2),PAF(3)); }
  #undef PKW
  #undef PAF
  #undef VFR
  #undef PIN
  #undef MX3
  #undef GAPA
  #undef GAPB
  #undef EX
  #undef VRD
  #undef KRD
  #undef STEP
  #undef ENDW
  {auto rr=__builtin_amdgcn_permlane32_swap(__float_as_uint(l_reg),__float_as_uint(l_reg),false,false);l_reg=__uint_as_float(rr[0])+__uint_as_float(rr[1]);}
  if(hi==0)wsf[32+r32]=l_reg;asm volatile("s_waitcnt lgkmcnt(0)":::"memory");
  float rli[16];
  #pragma unroll
  for(int r=0;r<16;++r)rli[r]=__builtin_amdgcn_rcpf(wsf[32+crow(r,hi)]);
  bf16*Ow=O+(rowbase+q0+wid*QBLK)*OPITCH+h*D;
  { bf16*stg=(bf16*)(shm+LDS_OST)+wid*2048;
    #pragma unroll
    for(int r=0;r<16;++r){const int orow=crow(r,hi);
      #pragma unroll
      for(int d0=0;d0<2;++d0)stg[orow*64+d0*32+r32]=(bf16)(cvtpk_s(o[d0][r]*rli[r],0.f)&0xffffu);}
    asm volatile("s_waitcnt lgkmcnt(0)":::"memory");
    #pragma unroll
    for(int i=0;i<4;++i){const int row=i*8+(lane>>3),ch=lane&7; const u32x4 v=*(const u32x4*)(stg+row*64+ch*8); *(u32x4*)(Ow+(long)row*OPITCH+ch*8)=v;} }
  asm volatile("s_waitcnt lgkmcnt(0)\n\ts_barrier":::"memory");
  #undef DMA_K
  #undef DMA_V
  #undef TILE
  #undef KREL
  #undef FIXUP
  #undef INIT
  #undef START
  #undef RESC
  #undef ROT
}
#undef SBAR
#undef WAIT_BAR
}

typedef __attribute__((address_space(4))) const char* karg_ptr;
struct Frame {
    LAS unsigned char* lds;
    volatile LAS unsigned* MISC;
    int tid, lane, wave, vcu, G;
    karg_ptr ka;
    __device__ __forceinline__ const float* inp(int i) const { return *(const float* const __attribute__((address_space(4)))*)(ka + 8 * i); }
    __device__ __forceinline__ float* outp() const { return *(float* const __attribute__((address_space(4)))*)(ka + 8 * 17); }
    __device__ __forceinline__ unsigned char* wsp() const { return *(unsigned char* const __attribute__((address_space(4)))*)(ka + 8 * 18); }
    __device__ __forceinline__ gu32* ctl() const { return (gu32*)(wsp() + WS_CTL); }
    __device__ __forceinline__ bf16_t* XB() const { return (bf16_t*)(wsp() + WS_XB); }
    __device__ __forceinline__ bf16_t* Z() const { return (bf16_t*)(wsp() + WS_Z); }
    __device__ __forceinline__ bf16_t* Y() const { return (bf16_t*)(wsp() + WS_Y); }
    __device__ __forceinline__ float* rss() const { return (float*)(wsp() + WS_RSS); }
    __device__ __forceinline__ float* rinvtok() const { return (float*)(wsp() + WS_RINV); }
    __device__ __forceinline__ float* kpart() const { return (float*)(wsp() + WS_KPART); }
    __device__ __forceinline__ float* grow() const { return (float*)(wsp() + WS_GROW); }
    __device__ __forceinline__ int* tokof() const { return (int*)(wsp() + WS_TOKOF); }
    __device__ __forceinline__ int* tslot() const { return (int*)(wsp() + WS_TSLOT); }
    __device__ __forceinline__ bf16_t* wsgu() const { return (bf16_t*)(wsp() + WS_WSGU); }
};
__device__ __forceinline__ void refresh(Frame& F) { int t = threadIdx.x; asm volatile("" : "+v"(t)); F.tid = t; F.lane = t & 63; }
enum { IN_X = 0, IN_GMIX, IN_WIN, IN_SGULN, IN_SGUW, IN_SGUB, IN_CONVW, IN_WOUT, IN_GFFN, IN_DWG, IN_DWU, IN_DWD, IN_ROUTER, IN_MWG, IN_MWU, IN_MWD, IN_GFINAL };

__device__ __forceinline__ void p0_item(const float* W, int N, const float* g, bf16_t* WT, int K, int drow0, int k0, int n0, LAS float* scr, int lane) {
#pragma unroll 8
    for (int i = 0; i < 32; ++i) { const int kk = 2 * i + (lane >> 5); scr[kk * 33 + (lane & 31)] = W[(size_t)(k0 + kk) * N + n0 + (lane & 31)]; }
    LDS_WAIT(); asm volatile("" ::: "memory");
    const int c = lane & 7;
    f32x4 g0 = (f32x4){1.f, 1.f, 1.f, 1.f}, g1 = g0;
    if (g) { g0 = *(const f32x4*)(g + k0 + 8 * c); g1 = *(const f32x4*)(g + k0 + 8 * c + 4); }
#pragma unroll
    for (int j = 0; j < 4; ++j) { const int n = (lane >> 3) + 8 * j; const LAS float* s = scr + (8 * c) * 33 + n;
        u32x4 o; o.x = cvt_pk_bf16(s[0 * 33] * g0[0], s[1 * 33] * g0[1]); o.y = cvt_pk_bf16(s[2 * 33] * g0[2], s[3 * 33] * g0[3]);
        o.z = cvt_pk_bf16(s[4 * 33] * g1[0], s[5 * 33] * g1[1]); o.w = cvt_pk_bf16(s[6 * 33] * g1[2], s[7 * 33] * g1[3]);
        *(u32x4*)(WT + (size_t)(drow0 + n) * K + k0 + 8 * c) = o; }
    LDS_WAIT(); asm volatile("" ::: "memory");
}
__device__ __forceinline__ void p0_prologue(Frame& F) {
    LAS float* scr = (LAS float*)(F.lds + F.wave * 16384);
    const int gw = F.vcu * NWAVES + F.wave, NGW = F.G * NWAVES;
    constexpr int IT_IN = 16 * 88, IT_OUT = 16 * 32, IT_GU = 16 * 88, IT_DN = 44 * 32;
    constexpr int NA = 2 * IT_IN, NBB = 2 * IT_OUT, NC = 18 * IT_GU, ND = 9 * IT_DN, NITEMS = NA + NBB + NC + ND;
    unsigned char* ws = F.wsp();
    for (int it = gw; it < NITEMS; it += NGW) {
        int r = it;
        if (r < NA) { const int l = r / IT_IN; r %= IT_IN; const int kb = r / 88, nb = r % 88;
            p0_item(F.inp(IN_WIN) + (size_t)l * D * INC, INC, F.inp(IN_GMIX) + l * D, (bf16_t*)(ws + WS_WIN) + (size_t)l * INC * D, D, 32 * nb, 64 * kb, 32 * nb, scr, F.lane); continue; }
        r -= NA;
        if (r < NBB) { const int l = r / IT_OUT; r %= IT_OUT; const int kb = r / 32, nb = r % 32;
            p0_item(F.inp(IN_WOUT) + (size_t)l * D * D, D, nullptr, (bf16_t*)(ws + WS_WOUT) + (size_t)l * D * D, D, 32 * nb, 64 * kb, 32 * nb, scr, F.lane); continue; }
        r -= NBB;
        if (r < NC) { const int mm = r / IT_GU; r %= IT_GU; const int set = mm >> 1, up = mm & 1; const int kb = r / 88, nb = r % 88, n0 = 32 * nb;
            const float* W = set == 0 ? (up ? F.inp(IN_DWU) : F.inp(IN_DWG)) : ((up ? F.inp(IN_MWU) : F.inp(IN_MWG)) + (size_t)(set - 1) * D * FF);
            bf16_t* WT = set == 0 ? (bf16_t*)(ws + WS_WGU0) : (bf16_t*)(ws + WS_MWGU) + (size_t)(set - 1) * GU * D;
            p0_item(W, FF, F.inp(IN_GFFN) + (set == 0 ? 0 : D), WT, D, (n0 >> 7) * 256 + up * 128 + (n0 & 127), 64 * kb, n0, scr, F.lane); continue; }
        r -= NC;
        { const int mm = r / IT_DN; r %= IT_DN; const int kb = r / 32, nb = r % 32;
            const float* W = mm == 0 ? F.inp(IN_DWD) : F.inp(IN_MWD) + (size_t)(mm - 1) * FF * D;
            bf16_t* WT = mm == 0 ? (bf16_t*)(ws + WS_WDN0) : (bf16_t*)(ws + WS_MWDN) + (size_t)(mm - 1) * D * FF;
            p0_item(W, D, nullptr, WT, FF, 32 * nb, 64 * kb, 32 * nb, scr, F.lane); }
    }
    { const float* sw = F.inp(IN_SGUW); bf16_t* wo = F.wsgu();
      for (int idx = (F.vcu * NWAVES + F.wave) * 64 + F.lane; idx < 2 * 4 * 128 * 16; idx += F.G * NWAVES * 64) {
          const int row = idx >> 4, s0 = (idx & 15) * 8, t = row & 127;
          const f32x4 a = *(const f32x4*)(sw + (size_t)row * 128 + s0), b = *(const f32x4*)(sw + (size_t)row * 128 + s0 + 4);
          float v[8] = {a[0], a[1], a[2], a[3], b[0], b[1], b[2], b[3]};
#pragma unroll
          for (int e = 0; e < 8; ++e) if (s0 + e > t) v[e] = 0.f;
          u32x4 w; w.x = cvt_pk_bf16(v[0], v[1]); w.y = cvt_pk_bf16(v[2], v[3]); w.z = cvt_pk_bf16(v[4], v[5]); w.w = cvt_pk_bf16(v[6], v[7]);
          *(u32x4*)(wo + (size_t)row * 128 + s0) = w; } }
    const float* x = F.inp(IN_X);
    for (int m = gw; m < T; m += NGW) {
        const f32x4* xr = (const f32x4*)(x + (size_t)m * D) + F.lane; float s = 0.f; u32x2* o8 = (u32x2*)(F.XB() + (size_t)m * D) + F.lane;
#pragma unroll
        for (int j = 0; j < 4; ++j) { const f32x4 v = xr[64 * j]; s += (v[0] * v[0] + v[1] * v[1]) + (v[2] * v[2] + v[3] * v[3]); u32x2 w; w.x = cvt_pk_bf16(v[0], v[1]); w.y = cvt_pk_bf16(v[2], v[3]); o8[64 * j] = w; }
        s = wave_sum(s);
        if (F.lane < 4) F.rss()[(size_t)F.lane * T + m] = F.lane == 0 ? s : 0.f;
    }
}

__device__ __forceinline__ void attn_simple_unit(Frame& F, int mode, int b, int h, int qb) {
    LAS float* Ks = (LAS float*)(F.lds);
    LAS float* Vs = Ks + 4096;
    LAS float* ksm = Vs + 4096;
    const int tid = F.tid, row = tid & 255, dh = tid >> 8;
    const int qoff = mode ? 2048 : 0, ycol = mode ? 768 : 0;
    const int tq = qb * 256 + row;
    const size_t tok = (size_t)b * SEQ + tq;
    float q[64];
    { const u32x4* qp = (const u32x4*)(F.Z() + tok * INC + qoff + h * 64);
#pragma unroll
      for (int i = 0; i < 8; ++i) { const u32x4 w = qp[i]; q[8 * i + 0] = bf_lo(w.x); q[8 * i + 1] = bf_hi(w.x); q[8 * i + 2] = bf_lo(w.y); q[8 * i + 3] = bf_hi(w.y); q[8 * i + 4] = bf_lo(w.z); q[8 * i + 5] = bf_hi(w.z); q[8 * i + 6] = bf_lo(w.w); q[8 * i + 7] = bf_hi(w.w); } }
    unsigned sel = 0u;
    __syncthreads();
    if (mode == 0) {
        { const int j = tid >> 6, d = tid & 63; float v = 0.f; if (j < qb) { const float* kp = F.kpart() + ((size_t)(b * 8 + j) * 2) * 256 + h * 64 + d; v = kp[0] + kp[256]; } ksm[tid] = v; }
        __syncthreads();
        float b0 = -INFINITY, b1 = -INFINITY, b2 = -INFINITY; int i0 = -1, i1 = -1, i2 = -1;
#pragma unroll 1
        for (int j = 0; j < qb; ++j) { float a0 = 0.f, a1 = 0.f, a2 = 0.f, a3 = 0.f; const LAS float* kj = ksm + j * 64;
#pragma unroll
            for (int d = 0; d < 64; d += 4) { const f32x4 kv = *(const LAS f32x4*)(kj + d); a0 += q[d] * kv[0]; a1 += q[d + 1] * kv[1]; a2 += q[d + 2] * kv[2]; a3 += q[d + 3] * kv[3]; }
            const float a = (a0 + a1) + (a2 + a3);
            if (a > b0) { b2 = b1; i2 = i1; b1 = b0; i1 = i0; b0 = a; i0 = j; } else if (a > b1) { b2 = b1; i2 = i1; b1 = a; i1 = j; } else if (a > b2) { b2 = a; i2 = j; } }
        if (i0 >= 0) sel |= 1u << i0; if (i1 >= 0) sel |= 1u << i1; if (i2 >= 0) sel |= 1u << i2;
    }
    float mx = -INFINITY, l = 0.f; float o[32];
#pragma unroll
    for (int d = 0; d < 32; ++d) o[d] = 0.f;
    const int ntl = 4 * (qb + 1);
#pragma unroll 1
    for (int tl = 0; tl < ntl; ++tl) {
        __syncthreads();
        { const int r = tid >> 3, ch = tid & 7; const bf16_t* kr = F.Z() + ((size_t)b * SEQ + tl * 64 + r) * INC + qoff + h * 64 + ch * 8;
          const u32x4 kw = *(const u32x4*)(kr + 256), vw = *(const u32x4*)(kr + 512);
          *(LAS f32x4*)(Ks + r * 64 + ch * 8) = (f32x4){bf_lo(kw.x), bf_hi(kw.x), bf_lo(kw.y), bf_hi(kw.y)}; *(LAS f32x4*)(Ks + r * 64 + ch * 8 + 4) = (f32x4){bf_lo(kw.z), bf_hi(kw.z), bf_lo(kw.w), bf_hi(kw.w)};
          *(LAS f32x4*)(Vs + r * 64 + ch * 8) = (f32x4){bf_lo(vw.x), bf_hi(vw.x), bf_lo(vw.y), bf_hi(vw.y)}; *(LAS f32x4*)(Vs + r * 64 + ch * 8 + 4) = (f32x4){bf_lo(vw.z), bf_hi(vw.z), bf_lo(vw.w), bf_hi(vw.w)}; }
        __syncthreads();
        const int jblk = tl >> 2;
        const bool tile_on = (mode != 0) || (jblk == qb) || ((sel >> jblk) & 1u);
#pragma unroll 1
        for (int key = 0; key < 64; ++key) {
            const int dist = tq - (tl * 64 + key);
            float bias = 0.f; bool valid;
            if (mode == 0) valid = tile_on && (jblk != qb || dist >= 0);
            else { int c = 0; if (dist >= 0) c = (dist <= 128 ? 1 : 0) + ((((dist & 3) == 0) && dist <= 512) ? 1 : 0) + (((dist & 15) == 0) ? 1 : 0);
                   valid = c > 0; bias = c == 3 ? 1.5849625007211562f : (c == 2 ? 1.f : 0.f); }
            if (valid) {
                const LAS float* kr = Ks + key * 64; float s0 = bias, s1 = 0.f, s2 = 0.f, s3 = 0.f;
#pragma unroll
                for (int d = 0; d < 64; d += 4) { const f32x4 kv = *(const LAS f32x4*)(kr + d); s0 += q[d] * kv[0]; s1 += q[d + 1] * kv[1]; s2 += q[d + 2] * kv[2]; s3 += q[d + 3] * kv[3]; }
                const float s = (s0 + s1) + (s2 + s3);
                if (s > mx) { const float a = fast_exp2(mx - s); l *= a;
#pragma unroll
                    for (int d = 0; d < 32; ++d) o[d] *= a;
                    mx = s; }
                const float p = fast_exp2(s - mx); l += p; const LAS float* vr = Vs + key * 64 + dh * 32;
#pragma unroll
                for (int d = 0; d < 32; d += 4) { const f32x4 vv = *(const LAS f32x4*)(vr + d); o[d] += p * vv[0]; o[d + 1] += p * vv[1]; o[d + 2] += p * vv[2]; o[d + 3] += p * vv[3]; }
            }
        }
    }
    { const float inv = 1.f / l;
      u32x4* yp = (u32x4*)(F.Y() + tok * D + ycol + h * 64 + dh * 32);
#pragma unroll
      for (int i = 0; i < 4; ++i) { u32x4 w; w.x = cvt_pk_bf16(o[8 * i] * inv, o[8 * i + 1] * inv); w.y = cvt_pk_bf16(o[8 * i + 2] * inv, o[8 * i + 3] * inv); w.z = cvt_pk_bf16(o[8 * i + 4] * inv, o[8 * i + 5] * inv); w.w = cvt_pk_bf16(o[8 * i + 6] * inv, o[8 * i + 7] * inv); yp[i] = w; } }
    __syncthreads();
}
__device__ __forceinline__ void sgu_simple_item(Frame& F, int l, int item) {
    LAS float* vn = (LAS float*)(F.lds);
    const int tok0 = item * 128;
    const float* lng = F.inp(IN_SGULN) + l * 256;
    __syncthreads();
    for (int t = F.wave; t < 128; t += NWAVES) {
        const bf16_t* zr = F.Z() + (size_t)(tok0 + t) * INC + 1024 + 4 * F.lane; const u32x2 w = *(const u32x2*)zr;
        float v[4] = {gelu_tanh(bf_lo(w.x)), gelu_tanh(bf_hi(w.x)), gelu_tanh(bf_lo(w.y)), gelu_tanh(bf_hi(w.y))};
        const float mean = wave_sum((v[0] + v[1]) + (v[2] + v[3])) * (1.f / 256.f);
        float s2 = 0.f;
#pragma unroll
        for (int e = 0; e < 4; ++e) { v[e] -= mean; s2 += v[e] * v[e]; }
        const float rstd = __builtin_amdgcn_rsqf(wave_sum(s2) * (1.f / 256.f) + LN_EPS);
        const f32x4 gg = *(const f32x4*)(lng + 4 * F.lane);
        *(LAS f32x4*)(vn + t * 256 + 4 * F.lane) = (f32x4){v[0] * rstd * gg[0], v[1] * rstd * gg[1], v[2] * rstd * gg[2], v[3] * rstd * gg[3]};
    }
    __syncthreads();
    const int c = F.tid & 255, th = F.tid >> 8, g = c >> 6;
    const float* Wg = F.inp(IN_SGUW) + ((size_t)l * 4 + g) * 128 * 128;
    const float* bs = F.inp(IN_SGUB) + ((size_t)l * 4 + g) * 128;
    for (int tt = 0; tt < 64; ++tt) {
        const int t = th * 64 + tt; const float* wrow = Wg + t * 128; float a = 0.f;
        for (int s = 0; s <= t; ++s) a += wrow[s] * vn[s * 256 + c];
        const size_t tok = (size_t)tok0 + t;
        const float u = gelu_tanh(bf_lo((unsigned)F.Z()[tok * INC + 768 + c]));
        const float y = u * (a + bs[t]);
        F.Y()[tok * D + 256 + c] = (bf16_t)(cvt_pk_bf16(y, 0.f) & 0xffffu);
    }
    __syncthreads();
}
__device__ __forceinline__ void conv_simple_item(Frame& F, int l, int item) {
    const int c = F.tid & 255, th = F.tid >> 8; const int tok0 = item * 64 + th * 32;
    const float* cw = F.inp(IN_CONVW) + (size_t)l * 3 * 256;
    const float w0 = cw[c], w1 = cw[256 + c], w2 = cw[512 + c];
    float zm2 = 0.f, zm1 = 0.f;
    const int p0 = tok0 & (SEQ - 1);
    if (p0 >= 2) { const bf16_t* z = F.Z() + (size_t)(tok0 - 2) * INC; zm2 = bf_lo((unsigned)z[1536 + c]) * bf_lo((unsigned)z[1792 + c]); }
    if (p0 >= 1) { const bf16_t* z = F.Z() + (size_t)(tok0 - 1) * INC; zm1 = bf_lo((unsigned)z[1536 + c]) * bf_lo((unsigned)z[1792 + c]); }
    for (int t = 0; t < 32; ++t) {
        const bf16_t* z = F.Z() + (size_t)(tok0 + t) * INC;
        const float zc = bf_lo((unsigned)z[1536 + c]) * bf_lo((unsigned)z[1792 + c]);
        const float y = bf_lo((unsigned)z[1280 + c]) * (w0 * zm2 + w1 * zm1 + w2 * zc);
        F.Y()[(size_t)(tok0 + t) * D + 512 + c] = (bf16_t)(cvt_pk_bf16(y, 0.f) & 0xffffu);
        zm2 = zm1; zm1 = zc;
    }
}
typedef float f32x16m __attribute__((ext_vector_type(16)));
__device__ __forceinline__ void sgu_conv_item(Frame& F, int l, int hitem, int citem) {
    const int item = hitem >> 1, gp = hitem & 1;
    LAS bf16_t* vnT = (LAS bf16_t*)(F.lds);
    const int tok0 = item * 128;
    const bf16_t* __restrict__ Z = F.Z(); bf16_t* __restrict__ Y = F.Y();
    {
        const int cg = F.tid & 31, ts = F.tid >> 5; const int ctok0 = citem * 64 + ts * 4, cc0 = 8 * cg; const int p0 = ctok0 & (SEQ - 1);
        u32x4 cA[6], cB[6], cG[4];
#pragma unroll
        for (int i = 0; i < 6; ++i) { const int dt = i - 2; const bool ok = (dt >= 0) || (p0 + dt >= 0); const bf16_t* z = Z + (size_t)(ctok0 + (ok ? dt : 0)) * INC + cc0;
            cA[i] = *(const u32x4*)(z + 1536); cB[i] = *(const u32x4*)(z + 1792); if (i >= 2) cG[i - 2] = *(const u32x4*)(z + 1280);
            if (!ok) { cA[i] = (u32x4){0u, 0u, 0u, 0u}; } }
        const float* cw = F.inp(IN_CONVW) + (size_t)l * 3 * 256 + cc0;
        f32x4 cw0[2], cw1[2], cw2[2];
#pragma unroll
        for (int h = 0; h < 2; ++h) { cw0[h] = *(const f32x4*)(cw + 4 * h); cw1[h] = *(const f32x4*)(cw + 256 + 4 * h); cw2[h] = *(const f32x4*)(cw + 512 + 4 * h); }
#define UNPK8(dst, w_) do { dst[0] = bf_lo(w_.x); dst[1] = bf_hi(w_.x); dst[2] = bf_lo(w_.y); dst[3] = bf_hi(w_.y); dst[4] = bf_lo(w_.z); dst[5] = bf_hi(w_.z); dst[6] = bf_lo(w_.w); dst[7] = bf_hi(w_.w); } while (0)
        float zm2[8], zm1[8];
        { float a_[8], b_[8]; UNPK8(a_, cA[0]); UNPK8(b_, cB[0]);
#pragma unroll
          for (int e = 0; e < 8; ++e) zm2[e] = a_[e] * b_[e];
          UNPK8(a_, cA[1]); UNPK8(b_, cB[1]);
#pragma unroll
          for (int e = 0; e < 8; ++e) zm1[e] = a_[e] * b_[e]; }
#pragma unroll
        for (int t = 0; t < 4; ++t) { float a_[8], b_[8], bg[8], y[8]; UNPK8(a_, cA[t + 2]); UNPK8(b_, cB[t + 2]); UNPK8(bg, cG[t]);
#pragma unroll
            for (int e = 0; e < 8; ++e) { const float zc = a_[e] * b_[e]; y[e] = bg[e] * (cw0[e >> 2][e & 3] * zm2[e] + cw1[e >> 2][e & 3] * zm1[e] + cw2[e >> 2][e & 3] * zc); zm2[e] = zm1[e]; zm1[e] = zc; }
            u32x4 w; w.x = cvt_pk_bf16(y[0], y[1]); w.y = cvt_pk_bf16(y[2], y[3]); w.z = cvt_pk_bf16(y[4], y[5]); w.w = cvt_pk_bf16(y[6], y[7]);
            *(u32x4*)(Y + (size_t)(ctok0 + t) * D + 512 + cc0) = w; }
#undef UNPK8
    }
    const int t1 = F.tid >> 2, qd = F.tid & 3;
    u32x4 vw[8];
    { const u32x4* zp = (const u32x4*)(Z + (size_t)(tok0 + t1) * INC + 1024 + 64 * qd);
#pragma unroll
      for (int i = 0; i < 8; ++i) vw[i] = zp[i]; }
    const int gl = F.wave >> 2, th = (F.wave >> 1) & 1, cn = F.wave & 1, g = 2 * gp + gl;
    const int r32 = F.lane & 31, hi = F.lane >> 5;
    const int c = 64 * g + 32 * cn + r32;
    bf16x8 af[2][8];
    { const bf16_t* Wg = F.wsgu() + ((size_t)(l * 4 + g) * 128) * 128;
#pragma unroll
      for (int tm = 0; tm < 2; ++tm)
#pragma unroll
          for (int ks = 0; ks < 8; ++ks) af[tm][ks] = *(const bf16x8*)(Wg + (size_t)(64 * th + 32 * tm + r32) * 128 + 8 * hi + 16 * ks); }
    unsigned uu[2][8];
    const float* bs = F.inp(IN_SGUB) + (size_t)(l * 4 + g) * 128;
#pragma unroll
    for (int tm = 0; tm < 2; ++tm)
#pragma unroll
        for (int r = 0; r < 16; r += 2) { const int t = 64 * th + 32 * tm + (r & 3) + 8 * (r >> 2) + 4 * hi;
            uu[tm][r >> 1] = (unsigned)Z[(size_t)(tok0 + t) * INC + 768 + c] | ((unsigned)Z[(size_t)(tok0 + t + 1) * INC + 768 + c] << 16); }
    __syncthreads();
    { float v[64]; float sm = 0.f;
#pragma unroll
      for (int i = 0; i < 8; ++i) { const u32x4 w = vw[i];
          v[8 * i + 0] = gelu_tanh(bf_lo(w.x)); v[8 * i + 1] = gelu_tanh(bf_hi(w.x)); v[8 * i + 2] = gelu_tanh(bf_lo(w.y)); v[8 * i + 3] = gelu_tanh(bf_hi(w.y));
          v[8 * i + 4] = gelu_tanh(bf_lo(w.z)); v[8 * i + 5] = gelu_tanh(bf_hi(w.z)); v[8 * i + 6] = gelu_tanh(bf_lo(w.w)); v[8 * i + 7] = gelu_tanh(bf_hi(w.w));
#pragma unroll
          for (int e = 0; e < 8; ++e) sm += v[8 * i + e]; }
      sm += __shfl_xor(sm, 1); sm += __shfl_xor(sm, 2);
      const float mean = sm * (1.f / 256.f); float s2 = 0.f;
#pragma unroll
      for (int i = 0; i < 64; ++i) { v[i] -= mean; s2 += v[i] * v[i]; }
      s2 += __shfl_xor(s2, 1); s2 += __shfl_xor(s2, 2);
      const float rstd = __builtin_amdgcn_rsqf(s2 * (1.f / 256.f) + LN_EPS);
      if ((qd >> 1) == gp) { const float* lng = F.inp(IN_SGULN) + l * 256 + 64 * qd; LAS bf16_t* dst = vnT + (size_t)(64 * (qd & 1)) * 136 + t1;
#pragma unroll
          for (int i = 0; i < 64; i += 4) { const f32x4 gg = *(const f32x4*)(lng + i);
#pragma unroll
              for (int e = 0; e < 4; ++e) dst[(i + e) * 136] = (bf16_t)(cvt_pk_bf16(v[i + e] * rstd * gg[e], 0.f) & 0xffffu);
              if ((i & 12) == 12) asm volatile("" ::: "memory"); } }
    }
    __syncthreads();
    {
#pragma unroll
      for (int tm = 0; tm < 2; ++tm) {
          const int t0 = 64 * th + 32 * tm; f32x16m a = {};
          const int nks = (t0 + 32) >> 4;
          const LAS bf16_t* vrow = vnT + (size_t)(64 * gl + 32 * cn + r32) * 136 + 8 * hi;
#pragma unroll
          for (int ks = 0; ks < 8; ++ks) if (ks < nks) { const bf16x8 bfr = *(const LAS bf16x8*)(vrow + 16 * ks); a = __builtin_amdgcn_mfma_f32_32x32x16_bf16(af[tm][ks], bfr, a, 0, 0, 0); }
#pragma unroll
          for (int r = 0; r < 16; ++r) { const int t = t0 + (r & 3) + 8 * (r >> 2) + 4 * hi;
              const float u = gelu_tanh((r & 1) ? bf_hi(uu[tm][r >> 1]) : bf_lo(uu[tm][r >> 1]));
              const float y = u * (a[r] + bs[t]);
              Y[(size_t)(tok0 + t) * D + 256 + c] = (bf16_t)(cvt_pk_bf16(y, 0.f) & 0xffffu); } }
    }
    __syncthreads();
}
#ifndef MIXP
#define MIXP 7
#endif
#ifndef SIMPLE_SGU
#define SIMPLE_SGU 0
#endif
#ifndef SIMPLE_ATTN
#define SIMPLE_ATTN 0
#endif
#ifndef REPA0
#define REPA0 1
#endif
#ifndef REPA1
#define REPA1 1
#endif
#ifndef REPSC
#define REPSC 1
#endif
__device__ __forceinline__ void mixers_phase(Frame& F, int l, char* shm) {
    if (MIXP & 1) for (int v = F.vcu; v < 256; v += F.G) {
        const int mode = v >> 7, bh = (v & 127) >> 2, s = v & 3, b = bh >> 2, h = bh & 3;
#if SIMPLE_ATTN
        attn_simple_unit(F, mode, b, h, s);
        attn_simple_unit(F, mode, b, h, 7 - s);
#else
        const bf16_t* Z = F.Z(); bf16_t* Y = F.Y();
#ifndef ATTN_MODES
#define ATTN_MODES 3
#endif
        if (mode == 0 && (ATTN_MODES & 1)) {
            attn_body::stage_ksum(shm, F.kpart(), b, h);
#pragma unroll 1
            for (int i = 0; i < 2 * REPA0; ++i) attn_body::attn_unit<0, 8>(b, h, (i & 1) == 0 ? 7 - s : s, Z, Z + 256, Z + 512, Y, shm);
        } else if (ATTN_MODES & 2) {
            attn_body::build_dil_lut(shm);
#pragma unroll 1
            for (int i = 0; i < 2 * REPA1; ++i) attn_body::attn_unit<1, 8>(b, h, (i & 1) == 0 ? 7 - s : s, Z + 2048, Z + 2304, Z + 2560, Y + 768, shm);
        }
#endif
    }
#if SIMPLE_SGU
    if (MIXP & 2) for (int it = F.vcu; it < 128; it += F.G) sgu_simple_item(F, l, it);
    if (MIXP & 4) for (int it = F.vcu; it < 256; it += F.G) conv_simple_item(F, l, it);
#else
    for (int rsc = 0; rsc < REPSC; ++rsc) for (int it = F.vcu; it < 256; it += F.G) { refresh(F); sgu_conv_item(F, l, it, it); }
#endif
}

__device__ __forceinline__ void router_phase(Frame& F) {
    LAS int* pe = (LAS int*)(F.lds);
    LAS float* pg = (LAS float*)(F.lds + 512);
    [[maybe_unused]] const float* x1 = F.outp(); const float* gf = F.inp(IN_GFFN) + D; const float* rw = F.inp(IN_ROUTER);
    f32x4 w0[16], w1[16];
#pragma unroll
    for (int j = 0; j < 4; ++j)
#pragma unroll
        for (int e = 0; e < 4; ++e) { const int k = 4 * F.lane + 256 * j + e; const float g = gf[k]; w0[4 * j + e] = *(const f32x4*)(rw + (size_t)k * 8) * g; w1[4 * j + e] = *(const f32x4*)(rw + (size_t)k * 8 + 4) * g; }
    for (int grp = F.vcu; grp < T / 64; grp += F.G) {
        __syncthreads();
        for (int i = 0; i < 8; ++i) {
            const int tl = F.wave * 8 + i, tok = grp * 64 + tl;
#if RES_BF16
            const u32x2* xr = (const u32x2*)(F.XB() + (size_t)tok * D) + F.lane;
#else
            const f32x4* xr = (const f32x4*)(x1 + (size_t)tok * D) + F.lane;
#endif
            f32x4 a0 = (f32x4){0.f, 0.f, 0.f, 0.f}, a1 = a0; float ss = 0.f;
#pragma unroll
            for (int j = 0; j < 4; ++j) {
#if RES_BF16
                const u32x2 xw = xr[64 * j]; const f32x4 v = (f32x4){bf_lo(xw.x), bf_hi(xw.x), bf_lo(xw.y), bf_hi(xw.y)};
#else
                const f32x4 v = xr[64 * j];
#endif
                ss += (v[0] * v[0] + v[1] * v[1]) + (v[2] * v[2] + v[3] * v[3]);
#pragma unroll
                for (int e = 0; e < 4; ++e) { a0 += w0[4 * j + e] * v[e]; a1 += w1[4 * j + e] * v[e]; } }
            ss = wave_sum(ss); const float ri = __builtin_amdgcn_rsqf(ss * (1.f / D) + RMS_EPS);
            float lg[8];
#pragma unroll
            for (int e = 0; e < 4; ++e) { lg[e] = wave_sum(a0[e]) * ri; lg[4 + e] = wave_sum(a1[e]) * ri; }
            int e0 = 0; float v0 = lg[0];
#pragma unroll
            for (int e = 1; e < 8; ++e) if (lg[e] > v0) { v0 = lg[e]; e0 = e; }
            int e1 = -1; float v1 = -INFINITY;
#pragma unroll
            for (int e = 0; e < 8; ++e) if (e != e0 && lg[e] > v1) { v1 = lg[e]; e1 = e; }
            const float g0 = 1.f / (1.f + __expf(v1 - v0)), g1 = 1.f - g0;
            if (F.lane == 0) { pe[2 * tl] = e0; pe[2 * tl + 1] = e1; pg[2 * tl] = g0; pg[2 * tl + 1] = g1; F.rinvtok()[tok] = ri; }
        }
        __syncthreads();
        if (F.wave == 0) {
            const int elo = pe[F.lane], ehi = pe[64 + F.lane]; const float glo = pg[F.lane], ghi = pg[64 + F.lane];
            const unsigned long long ltm = (1ull << F.lane) - 1ull;
            int rlo = 0, rhi = 0, mycnt = 0;
#pragma unroll
            for (int e = 0; e < 8; ++e) { const unsigned long long mlo = __ballot(elo == e), mhi = __ballot(ehi == e); const int clo = __popcll(mlo);
                if (elo == e) rlo = __popcll(mlo & ltm); if (ehi == e) rhi = clo + __popcll(mhi & ltm); if (F.lane == e) mycnt = clo + __popcll(mhi); }
            int mybase = 0;
            if (F.lane < 8) mybase = (int)__hip_atomic_fetch_add((unsigned*)(F.ctl() + CW_CNT + F.lane), (unsigned)mycnt, RLX_AGENT);
            const int blo = __shfl(mybase, elo), bhi = __shfl(mybase, ehi);
            const int slo = elo * 16384 + blo + rlo, shi = ehi * 16384 + bhi + rhi;
            const int toklo = grp * 64 + (F.lane >> 1), tokhi = grp * 64 + 32 + (F.lane >> 1);
            F.tokof()[slo] = toklo; F.grow()[slo] = glo; F.tslot()[2 * toklo + (F.lane & 1)] = slo;
            F.tokof()[shi] = tokhi; F.grow()[shi] = ghi; F.tslot()[2 * tokhi + (F.lane & 1)] = shi;
        }
    }
}
__device__ __forceinline__ void moe_counts(Frame& F, int (&pb)[8], int (&cn)[8], int& nrb) {
    int acc = 0;
#pragma unroll
    for (int e = 0; e < 8; ++e) { const int c = (int)__builtin_amdgcn_readfirstlane(__hip_atomic_load((unsigned*)(F.ctl() + CW_CNT + e), RLX_AGENT)); cn[e] = c; pb[e] = acc; acc += (c + 255) >> 8; }
    nrb = acc;
}
__device__ __forceinline__ void final_phase(Frame& F) {
    int pb[8], cn[8], nrb; moe_counts(F, pb, cn, nrb);
    const bf16_t* YB = (const bf16_t*)(F.wsp() + WS_YB); const float* gfin = F.inp(IN_GFINAL);
    const int gw = F.vcu * NWAVES + F.wave, NGW = F.G * NWAVES;
    for (int m = gw; m < T; m += NGW) {
        const int s0 = F.tslot()[2 * m], s1 = F.tslot()[2 * m + 1];
        int r0 = s0 & 16383, r1 = s1 & 16383; const int e0 = s0 >> 14, e1 = s1 >> 14;
#pragma unroll
        for (int e = 0; e < 8; ++e) { if (e0 == e) r0 += pb[e] * 256; if (e1 == e) r1 += pb[e] * 256; }
        f32x4* xr = (f32x4*)(F.outp() + (size_t)m * D) + F.lane;
        const u32x2* y0 = (const u32x2*)(YB + (size_t)r0 * D) + F.lane; const u32x2* y1 = (const u32x2*)(YB + (size_t)r1 * D) + F.lane;
        f32x4 v[4]; float ss = 0.f;
#if RES_BF16
        const u32x2* xbr = (const u32x2*)(F.XB() + (size_t)m * D) + F.lane;
#endif
#pragma unroll
        for (int j = 0; j < 4; ++j) { const u32x2 a = y0[64 * j], b = y1[64 * j];
#if RES_BF16
            const u32x2 xw = xbr[64 * j]; f32x4 t = (f32x4){bf_lo(xw.x), bf_hi(xw.x), bf_lo(xw.y), bf_hi(xw.y)};
#else
            f32x4 t = xr[64 * j];
#endif
            t[0] += bf_lo(a.x) + bf_lo(b.x); t[1] += bf_hi(a.x) + bf_hi(b.x); t[2] += bf_lo(a.y) + bf_lo(b.y); t[3] += bf_hi(a.y) + bf_hi(b.y);
            v[j] = t; ss += (t[0] * t[0] + t[1] * t[1]) + (t[2] * t[2] + t[3] * t[3]); }
        const float ri = __builtin_amdgcn_rsqf(wave_sum(ss) * (1.f / D) + RMS_EPS);
#pragma unroll
        for (int j = 0; j < 4; ++j) { const f32x4 g = *((const f32x4*)gfin + F.lane + 64 * j); xr[64 * j] = v[j] * ri * g; }
    }
}

__device__ __forceinline__ int opaque_s(int v) { asm volatile("" : "+s"(v)); return v; }
struct Args { const float* in[17]; float* out; unsigned char* ws; int ph_lo, ph_hi; };
__global__ void __launch_bounds__(NWAVES * 64, 2) trunk_fwd(Args args) {
    extern __shared__ __attribute__((aligned(16))) unsigned char lds[];
    Frame F;
    F.lds = (LAS unsigned char*)lds;
    F.MISC = (volatile LAS unsigned*)(F.lds + MISC_OFF);
    F.tid = threadIdx.x; F.lane = F.tid & 63; F.wave = __builtin_amdgcn_readfirstlane(F.tid >> 6);
    F.G = gridDim.x; { const int bx = blockIdx.x; F.vcu = (F.G % 8 == 0) ? (bx % 8) * (F.G / 8) + bx / 8 : bx; }
    F.ka = (karg_ptr)__builtin_amdgcn_kernarg_segment_ptr();
    for (int u = F.tid; u < (LDS_BYTES - LDSCTL_OFF) / 4; u += NWAVES * 64) ((LAS unsigned*)(F.lds + LDSCTL_OFF))[u] = 0u;
    __syncthreads();
    XcdBarrier bar; bar.bar = (unsigned*)(F.ctl() + CW_BAR); bar.x = 0; bar.st = nullptr;
    if (MK_N_LAUNCHES == 1) bar = xcd_barrier_post((unsigned*)(F.ctl() + CW_BAR), F.MISC + 8);
#define GRID_BAR() do { if (MK_N_LAUNCHES == 1) xcd_barrier(bar); } while (0)
    const int lo = *(const int __attribute__((address_space(4)))*)(F.ka + 152), hi = *(const int __attribute__((address_space(4)))*)(F.ka + 156);
    (void)args;
#define IN(k) (lo <= (k) && (k) < hi)
#define BOTH(k) (IN(k) && IN((k) + 1))
    PG8_LAS unsigned char* glds = (PG8_LAS unsigned char*)F.lds;
    const int bx = (int)blockIdx.x;

    asm volatile("; MARK P0");
    if (PHC(0) && IN(0)) { for (int rep = 0; rep < REP0; ++rep) { refresh(F); p0_prologue(F); if (BOTH(0)) GRID_BAR(); } }
    for (int l = 0; l < 2; ++l) {
        const int pbase = 1 + 5 * l;
        asm volatile("; MARK IN_GEMM");
        if (PHC(1) && IN(pbase)) for (int rep = 0; rep < REP1; ++rep) {
            pg8::StaticOrder S; S.init(F.XB(), (const bf16_t*)(F.wsp() + WS_WIN) + (size_t)l * INC * D, T, INC, D, F.G, opaque_s(bx));
            pg8::EpiIn E{F.Z(), F.rss(), F.kpart()};
            pg8::gemm_phase<pg8::EpiIn, pg8::StaticOrder, true, true>(glds, D, S, E);
            if (BOTH(pbase)) GRID_BAR();
        }
        asm volatile("; MARK MIXERS");
        if (PHC(2) && IN(pbase + 1)) { for (int rep = 0; rep < REP2; ++rep) { refresh(F); mixers_phase(F, l, (char*)lds); if (BOTH(pbase + 1)) GRID_BAR(); } }
        asm volatile("; MARK OUT_GEMM");
        if (PHC(3) && IN(pbase + 2)) {
            pg8::StaticOrder S; S.init(F.Y(), (const bf16_t*)(F.wsp() + WS_WOUT) + (size_t)l * D * D, T, D, D, F.G, opaque_s(bx));
#if RES_BF16
            pg8::EpiResB E{F.XB(), F.rss()};
            if (F.G == 256) pg8::gemm_phase<pg8::EpiResB, pg8::StaticOrder, false, true>(glds, D, S, E);
#else
            pg8::EpiRes E{l == 0 ? F.inp(IN_X) : F.outp(), F.outp(), F.XB(), F.rss()};
            if (F.G == 256) pg8::gemm_phase<pg8::EpiRes, pg8::StaticOrder, false, true>(glds, D, S, E);
#endif
            if (BOTH(pbase + 2)) GRID_BAR();
        }
        if (l == 0) {
            asm volatile("; MARK DENSE_GU");
            if (PHC(4) && IN(4)) for (int rep = 0; rep < REP4; ++rep) {
                pg8::StaticOrder S; S.init(F.XB(), (const bf16_t*)(F.wsp() + WS_WGU0), T, GU, D, F.G, opaque_s(bx));
                pg8::EpiGU E{(bf16_t*)(F.wsp() + WS_H), F.rss()};
                pg8::gemm_phase<pg8::EpiGU, pg8::StaticOrder, true, true>(glds, D, S, E);
                if (BOTH(4)) GRID_BAR();
            }
            asm volatile("; MARK DENSE_DN");
            if (PHC(5) && IN(5)) {
                pg8::StaticOrder S; S.init((const bf16_t*)(F.wsp() + WS_H), (const bf16_t*)(F.wsp() + WS_WDN0), T, D, FF, F.G, opaque_s(bx));
#if RES_BF16
                pg8::EpiResB E{F.XB(), F.rss()};
                if (F.G == 256) pg8::gemm_phase<pg8::EpiResB, pg8::StaticOrder, false, true>(glds, FF, S, E);
#else
                pg8::EpiRes E{F.outp(), F.outp(), F.XB(), F.rss()};
                if (F.G == 256) pg8::gemm_phase<pg8::EpiRes, pg8::StaticOrder, false, true>(glds, FF, S, E);
#endif
                if (BOTH(5)) GRID_BAR();
            }
        }
    }
    asm volatile("; MARK ROUTER");
    if (PHC(6) && IN(9)) { refresh(F); router_phase(F); if (BOTH(9)) GRID_BAR(); }
    asm volatile("; MARK MOE_GU");
    if (PHC(7) && IN(10)) for (int rep = 0; rep < REP7; ++rep) {
        pg8::MoeGatherOrder S; int nrb; moe_counts(F, S.pb, S.cn, nrb);
        S.nM = nrb; S.nN = GU / 256; S.G = F.G; S.c = opaque_s(bx); S.A = (const char*)F.XB(); S.Bt = (const char*)(F.wsp() + WS_MWGU); S.tstep = (size_t)256 * D * 2; S.estride = (size_t)GU * D * 2; S.tokof = F.tokof();
        pg8::EpiGUMoe E{(bf16_t*)(F.wsp() + WS_MH), F.rinvtok(), F.tokof()};
        pg8::gemm_phase<pg8::EpiGUMoe, pg8::MoeGatherOrder, true, true>(glds, D, S, E);
        if (BOTH(10)) GRID_BAR();
    }
    asm volatile("; MARK MOE_DN");
    if (PHC(8) && IN(11)) for (int rep = 0; rep < REP8; ++rep) {
        pg8::MoePlainOrder S; int nrb; moe_counts(F, S.pb, S.cn, nrb);
        S.nM = nrb; S.nN = D / 256; S.G = F.G; S.c = opaque_s(bx); S.A = (const char*)(F.wsp() + WS_MH); S.Bt = (const char*)(F.wsp() + WS_MWDN); S.tstep = (size_t)256 * FF * 2; S.estride = (size_t)D * FF * 2; S.tokof = F.tokof();
        pg8::EpiDnMoe E{(bf16_t*)(F.wsp() + WS_YB), F.grow()};
        pg8::gemm_phase<pg8::EpiDnMoe, pg8::MoePlainOrder, true, true>(glds, FF, S, E);
        if (BOTH(11)) GRID_BAR();
    }
    asm volatile("; MARK FINAL");
    if (PHC(9) && IN(12)) { refresh(F); final_phase(F); }
#undef IN
#undef BOTH
#undef GRID_BAR
}

extern "C" void kernel_launch(void* const* d_in, const int* in_sizes, int n_in, void* d_out, int out_size, void* d_ws, size_t ws_size, hipStream_t stream) {
    static int grid = 0;
    if (grid == 0) {
        if (n_in != 17 || in_sizes[0] != T * D || out_size != T * D || ws_size < WS_END) { fprintf(stderr, "kernel_launch: unexpected shapes or workspace (n_in %d, out %d, ws %zu, need %zu); nothing launched\n", n_in, out_size, ws_size, (size_t)WS_END); grid = -1; return; }
        int dev = 0, cus = 0, per_cu = 0;
        if (hipGetDevice(&dev) != hipSuccess || hipDeviceGetAttribute(&cus, hipDeviceAttributeMultiprocessorCount, dev) != hipSuccess) { grid = -1; return; }
        if (hipFuncSetAttribute((const void*)trunk_fwd, hipFuncAttributeMaxDynamicSharedMemorySize, LDS_BYTES) != hipSuccess) { fprintf(stderr, "kernel_launch: hipFuncSetAttribute failed\n"); grid = -1; return; }
        if (hipOccupancyMaxActiveBlocksPerMultiprocessor(&per_cu, (const void*)trunk_fwd, NWAVES * 64, LDS_BYTES) != hipSuccess || per_cu < 1) { fprintf(stderr, "kernel_launch: occupancy query says %d blocks per CU\n", per_cu); (void)hipGetLastError(); grid = -1; return; }
        (void)hipGetLastError();
        grid = cus;
        if (grid != 256) fprintf(stderr, "kernel_launch: %d CUs; the residual GEMM phases need exactly 256 workgroups\n", grid);
    }
    if (grid < 0) return;
    if (hipMemsetAsync((char*)d_ws + WS_CTL, 0, CTL_ZERO_BYTES, stream) != hipSuccess) { fprintf(stderr, "kernel_launch: memset failed\n"); return; }
    Args a{};
    for (int i = 0; i < 17; ++i) a.in[i] = (const float*)d_in[i];
    a.out = (float*)d_out; a.ws = (unsigned char*)d_ws;
    if (MK_N_LAUNCHES == 1) {
        a.ph_lo = 0; a.ph_hi = NPHASE;
        void* kargs[] = {&a};
        const hipError_t le = hipLaunchCooperativeKernel((const void*)trunk_fwd, dim3(grid), dim3(NWAVES * 64), kargs, LDS_BYTES, stream);
        if (le != hipSuccess) fprintf(stderr, "kernel_launch: cooperative launch failed: %s (grid %d)\n", hipGetErrorName(le), grid);
    } else {
        for (int p = 0; p < NPHASE; ++p) { a.ph_lo = p; a.ph_hi = p + 1; hipLaunchKernelGGL(trunk_fwd, dim3(grid), dim3(NWAVES * 64), LDS_BYTES, stream, a); }
    }
}
```
